# Optimizing an MI355X kernel written in HIP

```python
import jax, jax.numpy as jnp
from jax import lax
import numpy as np

D_MODEL = 1024
BATCH = 16
SEQ = 2048
DEPTH = 2

PLE_DIM = 256
CHUNK = 128
SG_GROUPS = 4
SG_GROUP_DIM = 128
SG_WIDTH = SG_GROUPS * SG_GROUP_DIM
SB_HEADS = 8
SB_HEAD_DIM = 64
SB_WIDTH = SB_HEADS * SB_HEAD_DIM
AB_IN = 2 * SG_WIDTH + 3 * SB_WIDTH
AB_OUT = SG_WIDTH + SB_WIDTH
RET_HEADS = 4
RET_DK = D_MODEL // RET_HEADS
RET_DV = 2 * RET_DK
RET_QK = RET_HEADS * RET_DK
RET_V = RET_HEADS * RET_DV
RET_IN = 2 * RET_QK + 2 * RET_V
ROPE_BASE = 10000.0
D_FF = 2816
CONV_W = 3
RMS_EPS = 1e-6
LN_EPS = 1e-5
N_EVEN = (DEPTH + 1) // 2
N_ODD = DEPTH // 2

kernel_name = 'hybrid_sgmlp_stickbreak_retention_trunk'


def rms_norm(x, g):
    xf = x.astype(jnp.float32)
    y = xf * lax.rsqrt(jnp.mean(xf * xf, axis=-1, keepdims=True) + RMS_EPS)
    return (y * g.astype(jnp.float32)).astype(x.dtype)


def spatial_gating(u, v, ln_g, ln_b, w_s, b_s):
    Bn, S, _ = u.shape
    nc = S // CHUNK
    vf = v.astype(jnp.float32).reshape(Bn, nc, CHUNK, SG_GROUPS, SG_GROUP_DIM)
    mean = jnp.mean(vf, axis=-1, keepdims=True)
    var = jnp.mean(jnp.square(vf - mean), axis=-1, keepdims=True)
    g = ln_g.astype(jnp.float32).reshape(SG_GROUPS, SG_GROUP_DIM)
    b = ln_b.astype(jnp.float32).reshape(SG_GROUPS, SG_GROUP_DIM)
    vn = (vf - mean) * lax.rsqrt(var + LN_EPS) * g + b
    causal = jnp.tril(jnp.ones((CHUNK, CHUNK), dtype=bool))
    w = jnp.where(causal[None], w_s.astype(jnp.float32), 0.0)
    mixed = jnp.einsum('gts,bnsgc->bntgc', w, vn) + jnp.transpose(b_s.astype(jnp.float32))[None, None, :, :, None]
    out = u.reshape(Bn, nc, CHUNK, SG_GROUPS, SG_GROUP_DIM) * mixed.astype(u.dtype)
    return out.reshape(Bn, S, SG_WIDTH)


def stick_breaking_attention(q, k, v):
    Bn, S, H, Dh = q.shape
    qf = q.astype(jnp.float32) * (Dh ** -0.5)
    kf = k.astype(jnp.float32)
    vf = v.astype(jnp.float32)
    outs = []
    for i in range(S // CHUNK):
        q0 = i * CHUNK
        kv_len = q0 + CHUNK
        z = jnp.einsum('bthd,bshd->bhts', qf[:, q0:kv_len], kf[:, :kv_len])
        t_pos = q0 + jnp.arange(CHUNK)[:, None]
        s_pos = jnp.arange(kv_len)[None, :]
        causal = s_pos < t_pos
        neg_log_1m_beta = jnp.where(causal, jax.nn.softplus(z), 0.0)
        later = lax.cumsum(neg_log_1m_beta, axis=3, reverse=True) - neg_log_1m_beta
        log_a = jax.nn.log_sigmoid(z) - later
        a = jnp.where(causal, jnp.exp(log_a), 0.0)
        outs.append(jnp.einsum('bhts,bshd->bthd', a, vf[:, :kv_len]))
    return jnp.concatenate(outs, axis=1).astype(q.dtype)


def hybrid_sg_sb_mixer(h, w_in, ln_g, ln_b, w_s, b_s, w_out):
    Bn, S, _ = h.shape
    proj = h @ w_in
    u, v, q, k, vv = jnp.split(proj, [SG_WIDTH, 2 * SG_WIDTH, 2 * SG_WIDTH + SB_WIDTH, 2 * SG_WIDTH + 2 * SB_WIDTH], axis=-1)
    a_out = spatial_gating(jax.nn.gelu(u, approximate=False), jax.nn.gelu(v, approximate=False), ln_g, ln_b, w_s, b_s)
    q = q.reshape(Bn, S, SB_HEADS, SB_HEAD_DIM)
    k = k.reshape(Bn, S, SB_HEADS, SB_HEAD_DIM)
    vv = vv.reshape(Bn, S, SB_HEADS, SB_HEAD_DIM)
    b_out = stick_breaking_attention(q, k, vv).reshape(Bn, S, SB_WIDTH)
    return jnp.concatenate([a_out, b_out], axis=-1) @ w_out


def rotary(x):
    S = x.shape[1]
    half = x.shape[-1] // 2
    inv = 1.0 / (ROPE_BASE ** (jnp.arange(half, dtype=jnp.float32) / half))
    ang = jnp.arange(S, dtype=jnp.float32)[:, None] * inv[None, :]
    cos = jnp.cos(ang)[None, :, None, :]
    sin = jnp.sin(ang)[None, :, None, :]
    xf = x.astype(jnp.float32)
    x1, x2 = xf[..., :half], xf[..., half:]
    return jnp.concatenate([x1 * cos - x2 * sin, x2 * cos + x1 * sin], axis=-1)


def retention(q, k, v):
    Bn, S, H, Dk = q.shape
    Dv = v.shape[-1]
    nc = S // CHUNK
    log_gamma = jnp.log(1.0 - 2.0 ** (-5.0 - jnp.arange(H, dtype=jnp.float32)))
    idx = jnp.arange(CHUNK, dtype=jnp.float32)
    diff = idx[:, None] - idx[None, :]
    decay_intra = jnp.where(diff[None] >= 0, jnp.exp(diff[None] * log_gamma[:, None, None]), 0.0)
    zeta = jnp.exp((CHUNK - 1 - idx)[None, :] * log_gamma[:, None])
    xi = jnp.exp((idx + 1.0)[None, :] * log_gamma[:, None])
    chunk_decay = jnp.exp(CHUNK * log_gamma)

    def to_chunks(t):
        return t.astype(jnp.float32).reshape(Bn, nc, CHUNK, H, t.shape[-1]).transpose(1, 0, 3, 2, 4)

    qc, kc, vc = to_chunks(q), to_chunks(k), to_chunks(v)

    def step(state, inp):
        qi, ki, vi = inp
        inner = jnp.einsum('bhtd,bhsd->bhts', qi, ki) * decay_intra[None]
        o = jnp.einsum('bhts,bhsv->bhtv', inner, vi) + jnp.einsum('bhtd,bhdv->bhtv', qi, state) * xi[None, :, :, None]
        state = state * chunk_decay[None, :, None, None] + jnp.einsum('bhsd,bhsv->bhdv', ki * zeta[None, :, :, None], vi)
        return state, o

    state0 = jnp.zeros((Bn, H, Dk, Dv), jnp.float32)
    _, o = lax.scan(step, state0, (qc, kc, vc))
    return o.transpose(1, 0, 3, 2, 4).reshape(Bn, S, H, Dv)


def retention_mixer(h, w_in, gn_g, w_out):
    Bn, S, _ = h.shape
    q, k, v, g = jnp.split(h @ w_in, [RET_QK, 2 * RET_QK, 2 * RET_QK + RET_V], axis=-1)
    q = rotary(q.reshape(Bn, S, RET_HEADS, RET_DK))
    k = rotary(k.reshape(Bn, S, RET_HEADS, RET_DK)) * (RET_DK ** -0.5)
    o = retention(q, k, v.reshape(Bn, S, RET_HEADS, RET_DV))
    mean = jnp.mean(o, axis=-1, keepdims=True)
    var = jnp.mean(jnp.square(o - mean), axis=-1, keepdims=True)
    o = ((o - mean) * lax.rsqrt(var + LN_EPS)).reshape(Bn, S, RET_V) * gn_g.astype(jnp.float32)
    return (jax.nn.silu(g) * o.astype(h.dtype)) @ w_out


def conv_ffn(h, w_up, conv_w, conv_b, w_down):
    S = h.shape[1]
    a = h @ w_up
    ap = jnp.pad(a, ((0, 0), (CONV_W - 1, 0), (0, 0)))
    c = conv_b + sum(ap[:, j:j + S] * conv_w[j] for j in range(CONV_W))
    gate, up = jnp.split(c, 2, axis=-1)
    return (jax.nn.gelu(gate, approximate=False) * up) @ w_down


def setup_inputs(seed: int = 0) -> dict:
    key = jax.random.key(seed)
    ks = jax.random.split(key, 24)
    f32 = jnp.float32

    def nrm(k, shape, scale):
        return jax.random.normal(k, shape, f32) * scale

    def gain(k, shape):
        return 1.0 + 0.05 * jax.random.normal(k, shape, f32)

    return {
        'x': nrm(ks[0], (BATCH, SEQ, D_MODEL), 1.0),
        'p': nrm(ks[1], (DEPTH, BATCH, SEQ, PLE_DIM), 1.0),
        'mix_norm_g': gain(ks[2], (DEPTH, D_MODEL)),
        'ffn_norm_g': gain(ks[3], (DEPTH, D_MODEL)),
        'ple_norm_g': gain(ks[4], (DEPTH, D_MODEL)),
        'ab_w_in': nrm(ks[5], (N_EVEN, D_MODEL, AB_IN), D_MODEL ** -0.5),
        'sg_ln_g': gain(ks[6], (N_EVEN, SG_WIDTH)),
        'sg_ln_b': nrm(ks[7], (N_EVEN, SG_WIDTH), 0.02),
        'sg_w': nrm(ks[8], (N_EVEN, SG_GROUPS, CHUNK, CHUNK), CHUNK ** -0.5),
        'sg_b': 1.0 + nrm(ks[9], (N_EVEN, SG_GROUPS, CHUNK), 0.1),
        'ab_w_out': nrm(ks[10], (N_EVEN, AB_OUT, D_MODEL), AB_OUT ** -0.5),
        'ret_w_in': nrm(ks[11], (N_ODD, D_MODEL, RET_IN), D_MODEL ** -0.5),
        'ret_gn_g': gain(ks[12], (N_ODD, RET_V)),
        'ret_w_out': nrm(ks[13], (N_ODD, RET_V, D_MODEL), RET_V ** -0.5),
        'ffn_w_up': nrm(ks[14], (DEPTH, D_MODEL, 2 * D_FF), D_MODEL ** -0.5),
        'ffn_conv_w': nrm(ks[15], (DEPTH, CONV_W, 2 * D_FF), CONV_W ** -0.5),
        'ffn_conv_b': nrm(ks[16], (DEPTH, 2 * D_FF), 0.02),
        'ffn_w_down': nrm(ks[17], (DEPTH, D_FF, D_MODEL), D_FF ** -0.5),
        'ple_w_gate': nrm(ks[18], (DEPTH, D_MODEL, D_MODEL), D_MODEL ** -0.5),
        'ple_w_proj': nrm(ks[19], (DEPTH, PLE_DIM, D_MODEL), PLE_DIM ** -0.5),
        'ple_post_g': gain(ks[20], (DEPTH, D_MODEL)),
        'final_norm_g': gain(ks[21], (D_MODEL,)),
    }


def reference(x, p, mix_norm_g, ffn_norm_g, ple_norm_g, ab_w_in, sg_ln_g, sg_ln_b, sg_w, sg_b, ab_w_out,
              ret_w_in, ret_gn_g, ret_w_out, ffn_w_up, ffn_conv_w, ffn_conv_b, ffn_w_down,
              ple_w_gate, ple_w_proj, ple_post_g, final_norm_g):
    for i in range(DEPTH):
        h = rms_norm(x, mix_norm_g[i])
        if i % 2 == 0:
            e = i // 2
            x = x + hybrid_sg_sb_mixer(h, ab_w_in[e], sg_ln_g[e], sg_ln_b[e], sg_w[e], sg_b[e], ab_w_out[e])
        else:
            o = i // 2
            x = x + retention_mixer(h, ret_w_in[o], ret_gn_g[o], ret_w_out[o])
        x = x + conv_ffn(rms_norm(x, ffn_norm_g[i]), ffn_w_up[i], ffn_conv_w[i], ffn_conv_b[i], ffn_w_down[i])
        gate = jax.nn.sigmoid(rms_norm(x, ple_norm_g[i]) @ ple_w_gate[i])
        x = x + gate * rms_norm(p[i] @ ple_w_proj[i], ple_post_g[i])
    return rms_norm(x, final_norm_g)
```

```cpp
#include <hip/hip_runtime.h>
#include <hip/hip_cooperative_groups.h>
#include <cstdio>
#include <cstdint>
namespace cg = cooperative_groups;

#ifndef FUSED_FFN
#define FUSED_FFN 1
#endif
#ifndef MK_N_LAUNCHES
#define MK_N_LAUNCHES 1
#endif

#define LAS __attribute__((address_space(3)))
typedef unsigned short bf16_t;
typedef short bf16x8 __attribute__((ext_vector_type(8)));
typedef float f32x4 __attribute__((ext_vector_type(4)));
typedef float f32x2 __attribute__((ext_vector_type(2)));
typedef unsigned u32x4 __attribute__((ext_vector_type(4)));
typedef unsigned u32x2 __attribute__((ext_vector_type(2)));

constexpr int DM = 1024, BATCH = 16, SEQ = 2048, MT = BATCH * SEQ;
constexpr int PLE = 256, AB_IN = 2560, RET_QKV = 4096, RET_IN = 6144, RET_V = 2048, DFF = 2816, UPN = 5632;
constexpr int HDF = DFF / 2, MH = MT / 2;
constexpr float RMS_EPS = 1e-6f, LN_EPS = 1e-5f;
constexpr int NWAVES = 8, NTHR = 512;
constexpr int LDS_BYTES = 147456;

constexpr size_t MiB = 1u << 20;
constexpr size_t WS_SS = 0;
constexpr size_t WS_PPSS = 1 * MiB;
constexpr size_t WS_GN = 1 * MiB + 512 * 1024;
constexpr size_t WS_STAT_END = 3 * MiB;
constexpr size_t WS_ROPE = 3 * MiB;
constexpr size_t WS_W = 5 * MiB;
constexpr size_t WS_XB = 66 * MiB;
constexpr size_t WS_PB = 130 * MiB;
constexpr size_t WS_MIX = 162 * MiB;
constexpr size_t WS_BIG = 226 * MiB;
constexpr size_t WS_ACT = WS_BIG + 176 * MiB;
constexpr size_t WS_XB2 = 446 * MiB;
constexpr size_t WS_BAR = 512 * MiB - 16384;
constexpr size_t WS_END = 512 * MiB;
constexpr size_t W_ABIN = 0, W_ABOUT = W_ABIN + (size_t)AB_IN * DM, W_RETIN = W_ABOUT + (size_t)DM * DM, W_RETOUT = W_RETIN + (size_t)RET_IN * DM,
                 W_UP = W_RETOUT + (size_t)DM * RET_V, W_DOWN = W_UP + 2 * (size_t)UPN * DM, W_GATE = W_DOWN + 2 * (size_t)DM * DFF, W_PP = W_GATE + 2 * (size_t)DM * DM,
                 W_TOTAL = W_PP + 2 * (size_t)DM * PLE;
static_assert(W_TOTAL * 2 <= 61 * MiB, "weights fit");

__device__ __forceinline__ unsigned pk2(float lo, float hi);
__device__ __forceinline__ unsigned f2bf(float f) { return pk2(f, 0.f) & 0xffffu; }
__device__ __forceinline__ unsigned pk2(float lo, float hi) { unsigned r; asm("v_cvt_pk_bf16_f32 %0, %1, %2" : "=v"(r) : "v"(lo), "v"(hi)); return r; }
__device__ __forceinline__ float bflo(unsigned w) { return __builtin_bit_cast(float, w << 16); }
__device__ __forceinline__ float bfhi(unsigned w) { return __builtin_bit_cast(float, w & 0xffff0000u); }
__device__ __forceinline__ float wave_sum(float v) {
#pragma unroll
    for (int o = 1; o < 64; o <<= 1) v += __shfl_xor(v, o);
    return v;
}
__device__ __forceinline__ f32x2 gelu_pk(f32x2 v) {
    const f32x2 av = __builtin_elementwise_abs(v), d = av * 0.2316418882f + 1.0f;
    f32x2 t; t.x = __builtin_amdgcn_rcpf(d.x); t.y = __builtin_amdgcn_rcpf(d.y);
    f32x2 q = t * 0.5307027145f + (-0.7265760135f); q = q * t + 0.7107068705f; q = q * t + (-0.142248368f); q = q * t + 0.127414796f; q = q * t;
    const f32x2 s = (v * v) * (-0.72134752044f);
    f32x2 e; e.x = __builtin_amdgcn_exp2f(s.x); e.y = __builtin_amdgcn_exp2f(s.y);
    const f32x2 m = v * (q * e), r = v - m;
    f32x2 o; o.x = v.x < 0.f ? m.x : r.x; o.y = v.y < 0.f ? m.y : r.y; return o;
}
__device__ __forceinline__ f32x4 gelu4(f32x4 v) { const f32x2 a = gelu_pk((f32x2){v[0], v[1]}), b = gelu_pk((f32x2){v[2], v[3]}); return (f32x4){a.x, a.y, b.x, b.y}; }
__device__ __forceinline__ float fexp(float x) { return __builtin_amdgcn_exp2f(x * 1.44269504089f); }
__device__ __forceinline__ float softplus2_f(float z) { return fmaxf(z, 0.f) + __builtin_amdgcn_logf(1.f + __builtin_amdgcn_exp2f(-fabsf(z))); }
__device__ __forceinline__ float sigmoid_f(float z) { return __builtin_amdgcn_rcpf(1.f + fexp(-z)); }
__device__ __forceinline__ float rms_r(float ss) { return __builtin_amdgcn_rsqf(ss * (1.0f / DM) + RMS_EPS); }
__device__ __forceinline__ float dpp_ror1(float x) { return __builtin_bit_cast(float, __builtin_amdgcn_update_dpp(0, __builtin_bit_cast(int, x), 0x121, 0xF, 0xF, false)); }
__device__ __forceinline__ float dpp_ror2(float x) { return __builtin_bit_cast(float, __builtin_amdgcn_update_dpp(0, __builtin_bit_cast(int, x), 0x122, 0xF, 0xF, false)); }
__device__ __forceinline__ f32x4 ror1v(f32x4 v) { return (f32x4){dpp_ror1(v[0]), dpp_ror1(v[1]), dpp_ror1(v[2]), dpp_ror1(v[3])}; }
__device__ __forceinline__ f32x4 ror2v(f32x4 v) { return (f32x4){dpp_ror2(v[0]), dpp_ror2(v[1]), dpp_ror2(v[2]), dpp_ror2(v[3])}; }
__device__ __forceinline__ u32x2 pack4(f32x4 v) { return (u32x2){pk2(v[0], v[1]), pk2(v[2], v[3])}; }
__device__ __forceinline__ f32x4 unpack4(u32x2 w) { return (f32x4){bflo(w.x), bfhi(w.x), bflo(w.y), bfhi(w.y)}; }

namespace pg8 {
constexpr int BM = 256, BK = 64, HALF = 128, HTB = HALF * BK * 2, STAGE_BYTES = 8 * HTB, NXCD = 8, WGM = 8;
__device__ __forceinline__ int lds_byte(int r, int c) { const int st = (r >> 4) * 2 + (c >> 5), rr = r & 15, cc = c & 31, ob = rr * 64 + cc * 2; return st * 1024 + (ob ^ (((ob >> 9) & 1) << 5)); }
__device__ __forceinline__ void stage_rc(int b, int& R, int& C) { const int st = b / 1024, sb = b % 1024, swz = sb ^ (((sb >> 9) & 1) << 5); R = (st >> 1) * 16 + swz / 64; C = (st & 1) * 32 + (swz % 64) / 2; }
__device__ __forceinline__ int perm32(int rho) { const int n = rho >> 4, i = rho & 15; return 8 * (i >> 2) + 4 * n + (i & 3); }
struct Unit { int pm, pn; };
struct Gemm { const bf16_t* A; const bf16_t* Bt; int lda, ldb, M, N, K; };
struct StaticOrder {
    int nM, nN, nwg, G, c;
    __device__ void init(int M, int N, int G_, int c_) { nM = M / BM; nN = N / BM; nwg = nM * nN; G = G_; c = c_; }
    __device__ bool next(int i, Unit& u) const {
        const long L = (long)i * G + c; if (L >= nwg) return false;
        int wgid = (int)L; { const int q = nwg / NXCD, r = nwg % NXCD, xcd = wgid % NXCD, off = wgid / NXCD; wgid = (xcd < r ? xcd * (q + 1) : r * (q + 1) + (xcd - r) * q) + off; }
        const int nig = WGM * nN, gid = wgid / nig, fm = gid * WGM, gsz = (nM - fm) < WGM ? (nM - fm) : WGM;
        u.pm = fm + ((wgid % nig) % gsz); u.pn = (wgid % nig) / gsz; return true;
    }
};
template <class Epi>
__device__ __forceinline__ void gemm_phase(LAS unsigned char* lds, const Gemm g, const StaticOrder& S, const Epi& E) {
    const int tid = threadIdx.x, wid = __builtin_amdgcn_readfirstlane(tid >> 6), lane = tid & 63, wr = wid >> 2, wc = wid & 3, fr = lane & 15, fq = lane >> 4;
    const int K = g.K, nt = K / BK;
    unsigned voffA[2], voffB[2];
#pragma unroll
    for (int i = 0; i < 2; ++i) { int R, C; stage_rc(tid * 16 + i * 8192, R, C); const int Rb = (R & ~31) + perm32(R & 31);
        voffA[i] = (unsigned)(R * g.lda + C) * 2u; voffB[i] = (unsigned)(Rb * g.ldb + C) * 2u; }
    const size_t kstep = (size_t)(BK * 2);
    const size_t hstepA = (size_t)HALF * g.lda * 2, hstepB = (size_t)HALF * g.ldb * 2;
    const size_t tstepA = 2 * hstepA, tstepB = 2 * hstepB;
    const unsigned ldsw = (unsigned)wid * 1024u;
    const int aoff = lds_byte(wr * 64 + fr, fq * 8), boff = lds_byte(wc * 32 + fr, fq * 8);
#define PG8_SA(b, h) (((b) * 2 + (h)) * HTB)
#define PG8_SB(b, h) ((4 + (b) * 2 + (h)) * HTB)
#define PG8_STAGE(bufoff, gbase, voff) do { _Pragma("unroll") for (int _i = 0; _i < 2; ++_i) \
        __builtin_amdgcn_global_load_lds((const unsigned*)((const char*)(gbase) + (voff)[_i]), (LAS unsigned*)(lds + (bufoff) + ldsw + _i * 8192), 16, 0, 0); } while (0)
#define PG8_LDA(dst, b, h) do { _Pragma("unroll") for (int m = 0; m < 4; ++m) _Pragma("unroll") for (int k = 0; k < 2; ++k) dst[m][k] = *(const LAS bf16x8*)(lds + PG8_SA(b, h) + aoff + m * 2048 + k * 1024); } while (0)
#define PG8_LDB(dst, b, h) do { _Pragma("unroll") for (int n = 0; n < 2; ++n) _Pragma("unroll") for (int k = 0; k < 2; ++k) dst[n][k] = *(const LAS bf16x8*)(lds + PG8_SB(b, h) + boff + n * 2048 + k * 1024); } while (0)
#define PG8_MMA(ai, bj, At, Bt) do { __builtin_amdgcn_s_setprio(1); _Pragma("unroll") for (int m = 0; m < 4; ++m) _Pragma("unroll") for (int n = 0; n < 2; ++n) _Pragma("unroll") for (int k = 0; k < 2; ++k) \
        acc[ai][bj][m][n] = __builtin_amdgcn_mfma_f32_16x16x32_bf16(Bt[n][k], At[m][k], acc[ai][bj][m][n], 0, 0, 0); __builtin_amdgcn_s_setprio(0); } while (0)
#define PG8_WAIT_V(n) asm volatile("s_waitcnt vmcnt(" #n ")" ::: "memory")
#define PG8_WAIT_L(n) asm volatile("s_waitcnt lgkmcnt(" #n ")" ::: "memory")
#define PG8_BAR __builtin_amdgcn_s_barrier()
#define PG8_SCHED __builtin_amdgcn_sched_barrier(0)
    Unit cur, nxt; int ui = 0;
    if (!S.next(0, cur)) return;
    f32x4 acc[2][2][4][2];
#pragma unroll
    for (int a = 0; a < 2; ++a)
#pragma unroll
        for (int b = 0; b < 2; ++b)
#pragma unroll
            for (int m = 0; m < 4; ++m)
#pragma unroll
                for (int n = 0; n < 2; ++n) acc[a][b][m][n] = (f32x4){0.f, 0.f, 0.f, 0.f};
    bf16x8 At[4][2], B0[2][2], B1[2][2];
    const char* cA = (const char*)g.A + (size_t)cur.pm * tstepA; const char* cB = (const char*)g.Bt + (size_t)cur.pn * tstepB;
    PG8_STAGE(PG8_SB(0, 0), cB, voffB); PG8_STAGE(PG8_SB(0, 1), cB + hstepB, voffB); PG8_STAGE(PG8_SA(0, 0), cA, voffA); PG8_STAGE(PG8_SA(0, 1), cA + hstepA, voffA);
    if (wr == 1) PG8_BAR;
    PG8_WAIT_V(2); PG8_BAR;
    PG8_STAGE(PG8_SB(1, 0), cB + kstep, voffB); PG8_STAGE(PG8_SA(1, 0), cA + kstep, voffA); PG8_STAGE(PG8_SB(1, 1), cB + hstepB + kstep, voffB);
    PG8_WAIT_V(6); PG8_BAR;
    for (;;) {
        const bool has_next = S.next(ui + 1, nxt);
        const char* nA = has_next ? (const char*)g.A + (size_t)nxt.pm * tstepA : cA; const char* nB = has_next ? (const char*)g.Bt + (size_t)nxt.pn * tstepB : cB;
#pragma nounroll
        for (int t = 0; t < nt; t += 2) {
            const bool last = (t == nt - 2);
            const char* a1 = cA + (size_t)(t + 1) * kstep;
            const char* a2 = last ? nA : cA + (size_t)(t + 2) * kstep; const char* b2 = last ? nB : cB + (size_t)(t + 2) * kstep;
            const char* a3 = a2 + kstep; const char* b3 = b2 + kstep;
            PG8_LDB(B0, 0, 0); PG8_LDB(B1, 0, 1); PG8_SCHED; PG8_LDA(At, 0, 0); PG8_STAGE(PG8_SA(1, 1), a1 + hstepA, voffA);
            PG8_WAIT_V(8); PG8_WAIT_L(0); PG8_BAR; PG8_MMA(0, 0, At, B0); PG8_MMA(0, 1, At, B1); PG8_BAR; PG8_SCHED;
            PG8_LDA(At, 0, 1); PG8_STAGE(PG8_SB(0, 0), b2, voffB); PG8_STAGE(PG8_SB(0, 1), b2 + hstepB, voffB); PG8_STAGE(PG8_SA(0, 0), a2, voffA);
            PG8_WAIT_V(8); PG8_WAIT_L(0); PG8_BAR; PG8_MMA(1, 0, At, B0); PG8_MMA(1, 1, At, B1); PG8_BAR; PG8_SCHED;
            PG8_LDB(B0, 1, 0); PG8_LDB(B1, 1, 1); PG8_SCHED; PG8_LDA(At, 1, 0); PG8_STAGE(PG8_SA(0, 1), a2 + hstepA, voffA);
            PG8_WAIT_V(8); PG8_WAIT_L(0); PG8_BAR; PG8_MMA(0, 0, At, B0); PG8_MMA(0, 1, At, B1); PG8_BAR; PG8_SCHED;
            PG8_LDA(At, 1, 1); PG8_STAGE(PG8_SB(1, 0), b3, voffB); PG8_STAGE(PG8_SB(1, 1), b3 + hstepB, voffB); PG8_STAGE(PG8_SA(1, 0), a3, voffA);
            PG8_WAIT_V(8); PG8_WAIT_L(0); PG8_BAR; PG8_MMA(1, 0, At, B0); PG8_MMA(1, 1, At, B1); PG8_BAR; PG8_SCHED;
        }
        if (wr == 0) PG8_BAR;
        E(acc, cur, wr, wc, fr, fq);
        if (!has_next) break;
#pragma unroll
        for (int a = 0; a < 2; ++a)
#pragma unroll
            for (int b = 0; b < 2; ++b)
#pragma unroll
                for (int m = 0; m < 4; ++m)
#pragma unroll
                    for (int n = 0; n < 2; ++n) acc[a][b][m][n] = (f32x4){0.f, 0.f, 0.f, 0.f};
        cur = nxt; cA = nA; cB = nB; ++ui;
        if (wr == 1) PG8_BAR;
    }
    PG8_WAIT_V(0);
    PG8_BAR;
#undef PG8_SA
#undef PG8_SB
#undef PG8_STAGE
#undef PG8_LDA
#undef PG8_LDB
#undef PG8_MMA
#undef PG8_WAIT_V
#undef PG8_WAIT_L
#undef PG8_BAR
#undef PG8_SCHED
}

typedef f32x4 (&AccRef)[2][2][4][2];
#define EPI_SCHED __builtin_amdgcn_sched_barrier(0)
#define EPI_ROW(ai, m) (u.pm * 256 + (ai) * 128 + wr * 64 + (m) * 16 + fr)
#define EPI_COL(bj) (u.pn * 256 + (bj) * 128 + wc * 32 + 8 * fq)

#define EPI_IT_ROW(it) EPI_ROW((it) >> 2, (it) & 3)
#define EPI_LOAD_RR(ssp) float rr[8]; _Pragma("unroll") for (int it = 0; it < 8; ++it) rr[it] = (ssp)[EPI_IT_ROW(it)]; _Pragma("unroll") for (int it = 0; it < 8; ++it) rr[it] = rms_r(rr[it])
#define EPI_PACK8(v0, v1) (u32x4){pk2((v0)[0], (v0)[1]), pk2((v0)[2], (v0)[3]), pk2((v1)[0], (v1)[1]), pk2((v1)[2], (v1)[3])}
#define EPI_SQ8(x0, x1) (((x0)[0] * (x0)[0] + (x0)[1] * (x0)[1]) + ((x0)[2] * (x0)[2] + (x0)[3] * (x0)[3]) + ((x1)[0] * (x1)[0] + (x1)[1] * (x1)[1]) + ((x1)[2] * (x1)[2] + (x1)[3] * (x1)[3]))
struct EpiProj0 {
    bf16_t* O; const float* ss;
    __device__ __forceinline__ void operator()(AccRef acc, const Unit& u, int wr, int wc, int fr, int fq) const {
        asm volatile("" : "+v"(fr), "+v"(fq));
        const bool act = u.pn < 4;
        EPI_LOAD_RR(ss);
#pragma unroll
        for (int it = 0; it < 8; ++it) { const int ai = it >> 2, m = it & 3, row = EPI_IT_ROW(it);
#pragma unroll
            for (int bj = 0; bj < 2; ++bj) { f32x4 v0 = acc[ai][bj][m][0] * rr[it], v1 = acc[ai][bj][m][1] * rr[it];
                if (act) { v0 = gelu4(v0); v1 = gelu4(v1); }
                *(u32x4*)(O + (size_t)row * AB_IN + EPI_COL(bj)) = EPI_PACK8(v0, v1); } }
    }
};
struct EpiRes {
    const float* xin; float* xout; bf16_t* xb; float* ssout;
    __device__ __forceinline__ void operator()(AccRef acc, const Unit& u, int wr, int wc, int fr, int fq) const {
        asm volatile("" : "+v"(fr), "+v"(fq));
        f32x4 xc[2][2], xn[2][2];
#pragma unroll
        for (int bj = 0; bj < 2; ++bj) { const size_t p = (size_t)EPI_IT_ROW(0) * DM + EPI_COL(bj); xc[bj][0] = *(const f32x4*)(xin + p); xc[bj][1] = *(const f32x4*)(xin + p + 4); }
#pragma unroll
        for (int it = 0; it < 8; ++it) { const int ai = it >> 2, m = it & 3, row = EPI_IT_ROW(it);
            if (it + 1 < 8) {
#pragma unroll
                for (int bj = 0; bj < 2; ++bj) { const size_t p = (size_t)EPI_IT_ROW(it + 1) * DM + EPI_COL(bj); xn[bj][0] = *(const f32x4*)(xin + p); xn[bj][1] = *(const f32x4*)(xin + p + 4); } }
            float q = 0.f;
#pragma unroll
            for (int bj = 0; bj < 2; ++bj) { const size_t p = (size_t)row * DM + EPI_COL(bj);
                const f32x4 x0 = xc[bj][0] + acc[ai][bj][m][0], x1 = xc[bj][1] + acc[ai][bj][m][1];
                __builtin_nontemporal_store(x0, (f32x4*)(xout + p)); __builtin_nontemporal_store(x1, (f32x4*)(xout + p + 4));
                *(u32x4*)(xb + p) = EPI_PACK8(x0, x1);
                q += EPI_SQ8(x0, x1); }
            q += __shfl_xor(q, 16); q += __shfl_xor(q, 32);
            if (fq == 0) atomicAdd(ssout + row, q);
#pragma unroll
            for (int bj = 0; bj < 2; ++bj) { xc[bj][0] = xn[bj][0]; xc[bj][1] = xn[bj][1]; } }
    }
};
struct EpiPle {
    float* x; float* xo; bf16_t* xb; const float* ssin; float* ssout; const bf16_t* pp; const float* ppss; const float* postg;
    __device__ __forceinline__ void operator()(AccRef acc, const Unit& u, int wr, int wc, int fr, int fq) const {
        asm volatile("" : "+v"(fr), "+v"(fq));
        f32x4 pg[2][2];
#pragma unroll
        for (int bj = 0; bj < 2; ++bj) { pg[bj][0] = *(const f32x4*)(postg + EPI_COL(bj)); pg[bj][1] = *(const f32x4*)(postg + EPI_COL(bj) + 4); }
        f32x4 xc0, xc1, xn0, xn1; u32x4 pc, pn; float sc, sn_, qc, qn;
        { const size_t p = (size_t)EPI_IT_ROW(0) * DM + EPI_COL(0); xc0 = *(const f32x4*)(x + p); xc1 = *(const f32x4*)(x + p + 4); pc = *(const u32x4*)(pp + p); sc = ssin[EPI_IT_ROW(0)]; qc = ppss[EPI_IT_ROW(0)]; }
        float q = 0.f;
#pragma unroll
        for (int st = 0; st < 16; ++st) { const int it = st >> 1, bj = st & 1, ai = it >> 2, m = it & 3, row = EPI_IT_ROW(it);
            if (st + 1 < 16) { const int it1 = (st + 1) >> 1, bj1 = (st + 1) & 1; const size_t p = (size_t)EPI_IT_ROW(it1) * DM + EPI_COL(bj1);
                xn0 = *(const f32x4*)(x + p); xn1 = *(const f32x4*)(x + p + 4); pn = *(const u32x4*)(pp + p);
                if (bj1 == 0) { sn_ = ssin[EPI_IT_ROW(it1)]; qn = ppss[EPI_IT_ROW(it1)]; } }
            const float r = rms_r(sc), rp = rms_r(qc);
            const size_t p = (size_t)row * DM + EPI_COL(bj);
            const f32x4 p0 = (f32x4){bflo(pc.x), bfhi(pc.x), bflo(pc.y), bfhi(pc.y)}, p1 = (f32x4){bflo(pc.z), bfhi(pc.z), bflo(pc.w), bfhi(pc.w)};
            const f32x4 z0 = acc[ai][bj][m][0] * r, z1 = acc[ai][bj][m][1] * r;
            f32x4 g0, g1;
#pragma unroll
            for (int e = 0; e < 4; ++e) { g0[e] = sigmoid_f(z0[e]); g1[e] = sigmoid_f(z1[e]); }
            const f32x4 x0 = xc0 + g0 * (p0 * rp) * pg[bj][0], x1 = xc1 + g1 * (p1 * rp) * pg[bj][1];
            if (xo) { __builtin_nontemporal_store(x0, (f32x4*)(xo + p)); __builtin_nontemporal_store(x1, (f32x4*)(xo + p + 4)); }
            *(u32x4*)(xb + p) = EPI_PACK8(x0, x1);
            q += EPI_SQ8(x0, x1);
            if (bj == 1) { q += __shfl_xor(q, 16); q += __shfl_xor(q, 32); if (fq == 0) atomicAdd(ssout + row, q); q = 0.f; sc = sn_; qc = qn; }
            xc0 = xn0; xc1 = xn1; pc = pn; }
    }
};
struct EpiPp {
    bf16_t* O; float* ssout;
    __device__ __forceinline__ void operator()(AccRef acc, const Unit& u, int wr, int wc, int fr, int fq) const {
        asm volatile("" : "+v"(fr), "+v"(fq));
#pragma unroll
        for (int it = 0; it < 8; ++it) { const int ai = it >> 2, m = it & 3, row = EPI_IT_ROW(it); float q = 0.f;
#pragma unroll
            for (int bj = 0; bj < 2; ++bj) { const f32x4 x0 = acc[ai][bj][m][0], x1 = acc[ai][bj][m][1];
                *(u32x4*)(O + (size_t)row * DM + EPI_COL(bj)) = EPI_PACK8(x0, x1);
                q += EPI_SQ8(x0, x1); }
            q += __shfl_xor(q, 16); q += __shfl_xor(q, 32);
            if (fq == 0) atomicAdd(ssout + row, q); }
    }
};
struct EpiQkv {
    bf16_t* O; const float* ss; const float* cs; const float* sn;
    __device__ __forceinline__ void operator()(AccRef acc, const Unit& u, int wr, int wc, int fr, int fq) const {
        asm volatile("" : "+v"(fr), "+v"(fq));
        const bool rot = u.pn < 8; const int i0 = wc * 32 + 8 * fq;
        EPI_LOAD_RR(ss);
        if (rot) {
            const float l2g = __builtin_amdgcn_logf(1.0f - __builtin_amdgcn_exp2f(-5.0f - (float)(u.pn & 3))) * (u.pn < 4 ? 1.f : -1.f);
#pragma unroll
            for (int it = 0; it < 8; ++it) rr[it] *= __builtin_amdgcn_exp2f((float)(EPI_IT_ROW(it) & 63) * l2g); }
        f32x4 cc[2], sc[2], cn[2], sq[2];
        if (rot) {
#pragma unroll
            for (int n = 0; n < 2; ++n) { const int pos = EPI_IT_ROW(0) & (SEQ - 1); cc[n] = *(const f32x4*)(cs + pos * 128 + i0 + 4 * n); sc[n] = *(const f32x4*)(sn + pos * 128 + i0 + 4 * n); } }
#pragma unroll
        for (int it = 0; it < 8; ++it) { const int ai = it >> 2, m = it & 3, row = EPI_IT_ROW(it); const float r = rr[it];
            if (rot) {
                if (it + 1 < 8) {
#pragma unroll
                    for (int n = 0; n < 2; ++n) { const int pos = EPI_IT_ROW(it + 1) & (SEQ - 1); cn[n] = *(const f32x4*)(cs + pos * 128 + i0 + 4 * n); sq[n] = *(const f32x4*)(sn + pos * 128 + i0 + 4 * n); } }
#pragma unroll
                for (int n = 0; n < 2; ++n) { const f32x4 c = cc[n] * r, s_ = sc[n] * r;
                    const f32x4 x1 = acc[ai][0][m][n], x2 = acc[ai][1][m][n]; acc[ai][0][m][n] = x1 * c - x2 * s_; acc[ai][1][m][n] = x2 * c + x1 * s_; }
#pragma unroll
                for (int n = 0; n < 2; ++n) { cc[n] = cn[n]; sc[n] = sq[n]; } }
            else {
#pragma unroll
                for (int bj = 0; bj < 2; ++bj) { acc[ai][bj][m][0] = acc[ai][bj][m][0] * r; acc[ai][bj][m][1] = acc[ai][bj][m][1] * r; } }
#pragma unroll
            for (int bj = 0; bj < 2; ++bj) *(u32x4*)(O + (size_t)row * RET_QKV + EPI_COL(bj)) = EPI_PACK8(acc[ai][bj][m][0], acc[ai][bj][m][1]); }
    }
};
struct EpiGate {
    bf16_t* QKV; const float* ss; const float* gn; const float* gng;
    __device__ __forceinline__ void operator()(AccRef acc, const Unit& u, int wr, int wc, int fr, int fq) const {
        asm volatile("" : "+v"(fr), "+v"(fq));
        const int h = u.pn >> 1;
        f32x4 gg[2][2];
#pragma unroll
        for (int bj = 0; bj < 2; ++bj) { gg[bj][0] = *(const f32x4*)(gng + EPI_COL(bj)); gg[bj][1] = *(const f32x4*)(gng + EPI_COL(bj) + 4); }
        EPI_LOAD_RR(ss);
        f32x2 sts[8];
#pragma unroll
        for (int it = 0; it < 8; ++it) sts[it] = *(const f32x2*)(gn + ((size_t)EPI_IT_ROW(it) * 4 + h) * 2);
        u32x4 oc[2], on[2];
#pragma unroll
        for (int bj = 0; bj < 2; ++bj) oc[bj] = *(const u32x4*)(QKV + (size_t)EPI_IT_ROW(0) * RET_QKV + 2048 + EPI_COL(bj));
#pragma unroll
        for (int it = 0; it < 8; ++it) { const int ai = it >> 2, m = it & 3, row = EPI_IT_ROW(it); const float r = rr[it];
            if (it + 1 < 8) {
#pragma unroll
                for (int bj = 0; bj < 2; ++bj) on[bj] = *(const u32x4*)(QKV + (size_t)EPI_IT_ROW(it + 1) * RET_QKV + 2048 + EPI_COL(bj)); }
            const float mean = sts[it].x * (1.f / 512.f), var = fmaxf(sts[it].y * (1.f / 512.f) - mean * mean, 0.f), rstd = __builtin_amdgcn_rsqf(var + LN_EPS);
#pragma unroll
            for (int bj = 0; bj < 2; ++bj) { const int col = EPI_COL(bj);
                const u32x4 ow = oc[bj];
                const f32x4 o0 = (f32x4){bflo(ow.x), bfhi(ow.x), bflo(ow.y), bfhi(ow.y)}, o1 = (f32x4){bflo(ow.z), bfhi(ow.z), bflo(ow.w), bfhi(ow.w)};
                const f32x4 z0 = acc[ai][bj][m][0] * r, z1 = acc[ai][bj][m][1] * r;
                f32x4 g0, g1;
#pragma unroll
                for (int e = 0; e < 4; ++e) { g0[e] = z0[e] * sigmoid_f(z0[e]); g1[e] = z1[e] * sigmoid_f(z1[e]); }
                const f32x4 y0 = g0 * ((o0 - mean) * rstd) * gg[bj][0], y1 = g1 * ((o1 - mean) * rstd) * gg[bj][1];
                *(u32x4*)(QKV + (size_t)row * RET_QKV + col) = EPI_PACK8(y0, y1); }
#pragma unroll
            for (int bj = 0; bj < 2; ++bj) oc[bj] = on[bj]; }
    }
};
struct EpiPlain {
    bf16_t* O; const float* ss;
    __device__ __forceinline__ void operator()(AccRef acc, const Unit& u, int wr, int wc, int fr, int fq) const {
        asm volatile("" : "+v"(fr), "+v"(fq));
        EPI_LOAD_RR(ss);
#pragma unroll
        for (int it = 0; it < 8; ++it) { const int ai = it >> 2, m = it & 3, row = EPI_IT_ROW(it);
#pragma unroll
            for (int bj = 0; bj < 2; ++bj) { const f32x4 v0 = acc[ai][bj][m][0] * rr[it], v1 = acc[ai][bj][m][1] * rr[it];
                *(u32x4*)(O + (size_t)row * UPN + EPI_COL(bj)) = EPI_PACK8(v0, v1); } }
    }
};
struct EpiUp {
    bf16_t* act; float* edge; const float* ss; const float* cw; const float* cb;
    __device__ __forceinline__ void operator()(AccRef acc, const Unit& u, int wr, int wc, int fr, int fq) const {
        asm volatile("" : "+v"(fr), "+v"(fq));
        const int j0 = u.pn * 128 + wc * 32 + 8 * fq;
        u32x2 pa[2][2][4][2];
        { EPI_LOAD_RR(ss);
#pragma unroll
          for (int it = 0; it < 8; ++it)
#pragma unroll
              for (int bj = 0; bj < 2; ++bj)
#pragma unroll
                  for (int n = 0; n < 2; ++n) pa[it >> 2][bj][it & 3][n] = pack4(acc[it >> 2][bj][it & 3][n] * rr[it]); }
        __builtin_amdgcn_sched_barrier(0);
#pragma unroll
        for (int ai = 0; ai < 2; ++ai) {
            const int rowg = u.pm * 256 + ai * 128 + wr * 64; const int grp = rowg >> 6;
#pragma unroll
            for (int n = 0; n < 2; ++n) { const unsigned jn = (unsigned)(j0 + 4 * n);
                f32x4 cu[4];
                {
                    const f32x4 wu0 = *(const f32x4*)(cw + (DFF + jn)), wu1 = *(const f32x4*)(cw + (UPN + DFF + jn)), wu2 = *(const f32x4*)(cw + (2 * UPN + DFF + jn)), bu = *(const f32x4*)(cb + (DFF + jn));
                    f32x4 pu1 = (f32x4){0.f, 0.f, 0.f, 0.f}, pu2 = pu1;
#pragma unroll
                    for (int m = 0; m < 4; ++m) {
                        const f32x4 au = unpack4(pa[ai][1][m][n]);
                        const f32x4 ru1 = ror1v(au), ru2 = ror2v(au);
                        const f32x4 u1 = fr >= 1 ? ru1 : pu1, u2 = fr >= 2 ? ru2 : pu2;
                        if (m == 0 && fr < 2) *(f32x4*)(edge + (unsigned)((grp * 4 + fr) * UPN + DFF + jn)) = au;
                        if (m == 3 && fr >= 14) *(f32x4*)(edge + (unsigned)((grp * 4 + (fr - 12)) * UPN + DFF + jn)) = au;
                        cu[m] = bu + wu0 * u2 + wu1 * u1 + wu2 * au;
                        pu1 = ru1; pu2 = ru2; }
                }
                {
                    const f32x4 wg0 = *(const f32x4*)(cw + jn), wg1 = *(const f32x4*)(cw + (UPN + jn)), wg2 = *(const f32x4*)(cw + (2 * UPN + jn)), bg = *(const f32x4*)(cb + jn);
                    f32x4 pg1 = (f32x4){0.f, 0.f, 0.f, 0.f}, pg2 = pg1;
#pragma unroll
                    for (int m = 0; m < 4; ++m) { const int row = rowg + m * 16 + fr;
                        const f32x4 ag = unpack4(pa[ai][0][m][n]);
                        const f32x4 rg1 = ror1v(ag), rg2 = ror2v(ag);
                        const f32x4 g1 = fr >= 1 ? rg1 : pg1, g2 = fr >= 2 ? rg2 : pg2;
                        if (m == 0 && fr < 2) *(f32x4*)(edge + (unsigned)((grp * 4 + fr) * UPN + jn)) = ag;
                        if (m == 3 && fr >= 14) *(f32x4*)(edge + (unsigned)((grp * 4 + (fr - 12)) * UPN + jn)) = ag;
                        const f32x4 o = gelu4(bg + wg0 * g2 + wg1 * g1 + wg2 * ag) * cu[m];
                        if (!(m == 0 && fr < 2)) *(u32x2*)(act + (unsigned)(row * DFF + jn)) = pack4(o);
                        pg1 = rg1; pg2 = rg2; }
                }
            } }
    }
};
}

struct Args { const float* in[22]; float* out; unsigned char* ws; int ph_lo, ph_hi; };
enum { I_X = 0, I_P, I_MIXG, I_FFNG, I_PLEG, I_ABIN, I_SGLNG, I_SGLNB, I_SGW, I_SGB, I_ABOUT, I_RETIN, I_RETGN, I_RETOUT, I_UP, I_CONVW, I_CONVB, I_DOWN, I_PGATE, I_PPROJ, I_POSTG, I_FING };

struct TrD { const float* W; bf16_t* WT; const float* gk; int K, N, mode, sub; };
__device__ __forceinline__ TrD tr_decode(const Args& a, bf16_t* WB, int it) {
    constexpr int I0 = 16 * 80, I1 = 16 * 32, I2 = 16 * 192, I3 = 32 * 32, I4 = 16 * 176, I5 = 44 * 32, I6 = 16 * 32, I7 = 4 * 32;
    int r = it;
    if (r < I0) return TrD{a.in[I_ABIN], WB + W_ABIN, a.in[I_MIXG], DM, AB_IN, 1, r}; r -= I0;
    if (r < I1) return TrD{a.in[I_ABOUT], WB + W_ABOUT, nullptr, DM, DM, 0, r}; r -= I1;
    if (r < I2) return TrD{a.in[I_RETIN], WB + W_RETIN, a.in[I_MIXG] + DM, DM, RET_IN, 2, r}; r -= I2;
    if (r < I3) return TrD{a.in[I_RETOUT], WB + W_RETOUT, nullptr, RET_V, DM, 0, r}; r -= I3;
    if (r < 2 * I4) { const int l = r / I4; return TrD{a.in[I_UP] + (size_t)l * DM * UPN, WB + W_UP + (size_t)l * UPN * DM, a.in[I_FFNG] + l * DM, DM, UPN, 3, r % I4}; } r -= 2 * I4;
    if (r < 2 * I5) { const int l = r / I5; return TrD{a.in[I_DOWN] + (size_t)l * DFF * DM, WB + W_DOWN + (size_t)l * DM * DFF, nullptr, DFF, DM, 0, r % I5}; } r -= 2 * I5;
    if (r < 2 * I6) { const int l = r / I6; return TrD{a.in[I_PGATE] + (size_t)l * DM * DM, WB + W_GATE + (size_t)l * DM * DM, a.in[I_PLEG] + l * DM, DM, DM, 0, r % I6}; } r -= 2 * I6;
    { const int l = r / I7; return TrD{a.in[I_PPROJ] + (size_t)l * PLE * DM, WB + W_PP + (size_t)l * DM * PLE, nullptr, PLE, DM, 0, r % I7}; }
}
__device__ __forceinline__ void tr_load(const TrD& d, float (&v)[32], int lane) {
    const int nblk = d.N / 32, kb = d.sub / nblk, nb = d.sub % nblk, k0 = 64 * kb, n0 = 32 * nb;
#pragma unroll
    for (int i = 0; i < 32; ++i) { const int kk = 2 * i + (lane >> 5); v[i] = d.W[(size_t)(k0 + kk) * d.N + n0 + (lane & 31)]; }
    if (d.gk) {
#pragma unroll
        for (int i = 0; i < 32; ++i) v[i] *= d.gk[k0 + 2 * i + (lane >> 5)]; }
}
__device__ __forceinline__ void tr_stage(const TrD& d, const float (&v)[32], LAS float* scr, int lane) {
    const int nblk = d.N / 32, kb = d.sub / nblk, nb = d.sub % nblk, k0 = 64 * kb, n0 = 32 * nb;
#pragma unroll
    for (int i = 0; i < 32; ++i) scr[(2 * i + (lane >> 5)) * 33 + (lane & 31)] = v[i];
    asm volatile("s_waitcnt lgkmcnt(0)" ::: "memory");
    float sc = 1.f; int d0 = n0;
    if (d.mode == 1 && n0 >= 1024 && n0 < 1536) sc = 0.125f * 1.44269504089f;
    if (d.mode == 2 && n0 >= 1024 && n0 < 2048) sc = 0.0625f;
#if FUSED_FFN
    if (d.mode == 3) d0 = n0 < DFF ? (n0 / 128) * 256 + (n0 % 128) : ((n0 - DFF) / 128) * 256 + 128 + ((n0 - DFF) % 128);
#endif
    const int c = lane & 7;
#pragma unroll
    for (int j = 0; j < 4; ++j) { const int n = (lane >> 3) + 8 * j; const LAS float* s = scr + (8 * c) * 33 + n;
        u32x4 o; o.x = pk2(s[0 * 33] * sc, s[1 * 33] * sc); o.y = pk2(s[2 * 33] * sc, s[3 * 33] * sc); o.z = pk2(s[4 * 33] * sc, s[5 * 33] * sc); o.w = pk2(s[6 * 33] * sc, s[7 * 33] * sc);
        *(u32x4*)(d.WT + (size_t)(d0 + n) * d.K + k0 + 8 * c) = o; }
    asm volatile("s_waitcnt lgkmcnt(0)" ::: "memory");
}
__device__ __forceinline__ void p0_prologue(const Args& a, LAS unsigned char* lds) {
    const int tid = threadIdx.x, lane = tid & 63, wave = tid >> 6, G = gridDim.x;
    const int gw = blockIdx.x * NWAVES + wave, NGW = G * NWAVES;
    LAS float* scr = (LAS float*)(lds + wave * 17408);
    bf16_t* WB = (bf16_t*)(a.ws + WS_W);
    constexpr int NITEMS = 16 * 80 + 16 * 32 + 16 * 192 + 32 * 32 + 2 * (16 * 176) + 2 * (44 * 32) + 2 * (16 * 32) + 2 * (4 * 32);
    for (int it = gw; it < NITEMS; it += 2 * NGW) {
        const bool two = it + NGW < NITEMS;
        const TrD d0 = tr_decode(a, WB, it), d1 = tr_decode(a, WB, two ? it + NGW : it);
        float v0[32], v1[32];
        tr_load(d0, v0, lane); if (two) tr_load(d1, v1, lane);
        tr_stage(d0, v0, scr, lane); if (two) tr_stage(d1, v1, scr + 64 * 33, lane);
    }
    { const float* X = a.in[I_X]; bf16_t* XB = (bf16_t*)(a.ws + WS_XB); float* ss0 = (float*)(a.ws + WS_SS);
      for (int m0 = gw * 4; m0 < MT; m0 += NGW * 4) { f32x4 v[4][4];
#pragma unroll
          for (int rr = 0; rr < 4; ++rr) { const f32x4* xr = (const f32x4*)(X + (size_t)(m0 + rr) * DM) + lane;
#pragma unroll
              for (int j = 0; j < 4; ++j) v[rr][j] = xr[64 * j]; }
#pragma unroll
          for (int rr = 0; rr < 4; ++rr) { unsigned long long* o8 = (unsigned long long*)(XB + (size_t)(m0 + rr) * DM) + lane; float sq = 0.f;
#pragma unroll
              for (int j = 0; j < 4; ++j) { const f32x4 t = v[rr][j]; sq += (t.x * t.x + t.y * t.y) + (t.z * t.z + t.w * t.w); o8[64 * j] = (unsigned long long)pk2(t.x, t.y) | ((unsigned long long)pk2(t.z, t.w) << 32); }
              sq = wave_sum(sq); if (lane == 0) ss0[m0 + rr] = sq; } } }
    const size_t gt = (size_t)blockIdx.x * NTHR + tid, NT = (size_t)G * NTHR;
    { const float* P = a.in[I_P]; bf16_t* PB = (bf16_t*)(a.ws + WS_PB); constexpr size_t NG = (size_t)2 * MT * PLE / 8;
      for (size_t i0 = gt; i0 < NG; i0 += 4 * NT) { f32x4 v[4][2];
#pragma unroll
          for (int j = 0; j < 4; ++j) { const size_t i = i0 + j * NT; if (i < NG) { v[j][0] = *(const f32x4*)(P + i * 8); v[j][1] = *(const f32x4*)(P + i * 8 + 4); } }
#pragma unroll
          for (int j = 0; j < 4; ++j) { const size_t i = i0 + j * NT; if (i < NG) { u32x4 w; w.x = pk2(v[j][0].x, v[j][0].y); w.y = pk2(v[j][0].z, v[j][0].w); w.z = pk2(v[j][1].x, v[j][1].y); w.w = pk2(v[j][1].z, v[j][1].w); *(u32x4*)(PB + i * 8) = w; } } } }
    { f32x4* z = (f32x4*)(a.ws + WS_SS + (size_t)MT * 4); const size_t n = (WS_STAT_END - (size_t)MT * 4) / 16;
      for (size_t i = gt; i < n; i += NT) z[i] = (f32x4){0.f, 0.f, 0.f, 0.f}; }
    { float* cs = (float*)(a.ws + WS_ROPE); float* sn = cs + SEQ * 128;
      for (size_t i = gt; i < (size_t)SEQ * 128; i += NT) { const int pos = (int)(i >> 7), k = (int)(i & 127);
          const float inv = 1.0f / __builtin_amdgcn_exp2f((float)k * (1.0f / 128.0f) * 13.287712379549449f);
          const float ang = (float)pos * inv;
          double rev = (double)ang * 0.15915494309189535; rev -= floor(rev);
          const float fr = (float)rev;
          cs[i] = __builtin_amdgcn_cosf(fr); sn[i] = __builtin_amdgcn_sinf(fr); } }
}

#define LDS_BAR() do { asm volatile("s_waitcnt lgkmcnt(0)" ::: "memory"); __builtin_amdgcn_s_barrier(); asm volatile("" ::: "memory"); } while (0)
__device__ __forceinline__ void sg_unit(LAS unsigned char* lds, const bf16_t* P0, bf16_t* MIX, const float* lng, const float* lnb, const float* wsp, const float* bsp, int b, int nch, int g) {
    const int tid = threadIdx.x, lane = tid & 63, w = tid >> 6, fr = lane & 15, fq = lane >> 4;
    LAS bf16_t* vnl = (LAS bf16_t*)lds;
    LAS bf16_t* Wl = vnl + 128 * 136;
    const size_t rowbase = (size_t)b * SEQ + (size_t)nch * 128;
    __syncthreads();
    {
        const int s = tid >> 2, part = tid & 3;
        const bf16_t* vp = P0 + (rowbase + s) * AB_IN + 512 + 128 * g + 32 * part;
        float x[32]; float sum = 0.f;
#pragma unroll
        for (int j = 0; j < 4; ++j) { const u32x4 wv = *(const u32x4*)(vp + 8 * j);
            x[8 * j + 0] = bflo(wv.x); x[8 * j + 1] = bfhi(wv.x); x[8 * j + 2] = bflo(wv.y); x[8 * j + 3] = bfhi(wv.y);
            x[8 * j + 4] = bflo(wv.z); x[8 * j + 5] = bfhi(wv.z); x[8 * j + 6] = bflo(wv.w); x[8 * j + 7] = bfhi(wv.w); }
#pragma unroll
        for (int j = 0; j < 32; ++j) sum += x[j];
        sum += __shfl_xor(sum, 1); sum += __shfl_xor(sum, 2);
        const float mean = sum * (1.f / 128.f); float q = 0.f;
#pragma unroll
        for (int j = 0; j < 32; ++j) { x[j] -= mean; q += x[j] * x[j]; }
        q += __shfl_xor(q, 1); q += __shfl_xor(q, 2);
        const float rstd = __builtin_amdgcn_rsqf(q * (1.f / 128.f) + LN_EPS);
        const float* gp = lng + 128 * g + 32 * part; const float* bp = lnb + 128 * g + 32 * part;
#pragma unroll
        for (int j = 0; j < 4; ++j) { float y[8];
#pragma unroll
            for (int e = 0; e < 8; ++e) y[e] = x[8 * j + e] * rstd * gp[8 * j + e] + bp[8 * j + e];
            *(LAS u32x4*)(vnl + s * 136 + 32 * part + 8 * j) = (u32x4){pk2(y[0], y[1]), pk2(y[2], y[3]), pk2(y[4], y[5]), pk2(y[6], y[7])}; }
        const int t = tid >> 2, s0 = 32 * part; const float* wp = wsp + ((size_t)g * 128 + t) * 128 + s0;
#pragma unroll
        for (int j = 0; j < 4; ++j) { const f32x4 a0 = *(const f32x4*)(wp + 8 * j), a1 = *(const f32x4*)(wp + 8 * j + 4); const int sb = s0 + 8 * j;
            u32x4 o; o.x = pk2(sb + 0 <= t ? a0.x : 0.f, sb + 1 <= t ? a0.y : 0.f); o.y = pk2(sb + 2 <= t ? a0.z : 0.f, sb + 3 <= t ? a0.w : 0.f);
            o.z = pk2(sb + 4 <= t ? a1.x : 0.f, sb + 5 <= t ? a1.y : 0.f); o.w = pk2(sb + 6 <= t ? a1.z : 0.f, sb + 7 <= t ? a1.w : 0.f);
            *(LAS u32x4*)(Wl + t * 136 + sb) = o; }
    }
    __syncthreads();
    f32x4 acc[8];
#pragma unroll
    for (int mi = 0; mi < 8; ++mi) acc[mi] = (f32x4){0.f, 0.f, 0.f, 0.f};
    const int nks = ((16 * w + 15) >> 5) + 1;
    for (int ks = 0; ks < nks; ++ks) { const bf16x8 bfrag = *(const LAS bf16x8*)(Wl + (16 * w + fr) * 136 + 32 * ks + 8 * fq);
#pragma unroll
        for (int mi = 0; mi < 8; ++mi) { typedef short v4s __attribute__((ext_vector_type(4)));
            const LAS bf16_t* p_ = vnl + (32 * ks + 8 * fq + (fr >> 2)) * 136 + 16 * mi + 4 * (fr & 3);
            const v4s lo_ = __builtin_amdgcn_ds_read_tr16_b64_v4i16((LAS v4s*)p_), hi_ = __builtin_amdgcn_ds_read_tr16_b64_v4i16((LAS v4s*)(p_ + 4 * 136));
            const bf16x8 afrag = (bf16x8){lo_[0], lo_[1], lo_[2], lo_[3], hi_[0], hi_[1], hi_[2], hi_[3]};
            acc[mi] = __builtin_amdgcn_mfma_f32_16x16x32_bf16(afrag, bfrag, acc[mi], 0, 0, 0); } }
    const size_t trow = rowbase + 16 * w + fr; const float bias = bsp[g * 128 + 16 * w + fr];
#pragma unroll
    for (int mi = 0; mi < 8; ++mi) { const int c = 16 * mi + 4 * fq;
        const f32x4 uv = unpack4(*(const u32x2*)(P0 + trow * AB_IN + 128 * g + c));
        *(u32x2*)(MIX + trow * DM + 128 * g + c) = pack4((acc[mi] + bias) * uv); }
}
__device__ __forceinline__ void sb_unit(LAS unsigned char* lds, const bf16_t* P0, bf16_t* MIX, int b, int h, int qc) {
    const int tid = threadIdx.x, lane = tid & 63, w = tid >> 6, fr = lane & 15, fq = lane >> 4;
    LAS bf16_t* Kb2 = (LAS bf16_t*)lds;
    LAS bf16_t* Vb2 = Kb2 + 2 * 128 * 72;
    const size_t rowbase = (size_t)b * SEQ; const int q0 = qc * 128, tq = q0 + 16 * w + fr;
    const bf16_t* qp = P0 + (rowbase + tq) * AB_IN + 1024 + 64 * h + 8 * fq;
    const bf16x8 qf0 = *(const bf16x8*)qp, qf1 = *(const bf16x8*)(qp + 32);
    f32x4 oacc[4];
#pragma unroll
    for (int n = 0; n < 4; ++n) oacc[n] = (f32x4){0.f, 0.f, 0.f, 0.f};
    float R = 1.f;
    LAS unsigned* flags = (LAS unsigned*)(Vb2 + 2 * 128 * 72);
    u32x4 pkr[2], pvr[2];
    const int krow = tid >> 3, kc8 = tid & 7, vs_ = tid & 127, vc8 = tid >> 7;
#define SB_LOAD(kb_) do { _Pragma("unroll") for (int uu = 0; uu < 2; ++uu) { \
        pkr[uu] = *(const u32x4*)(P0 + (rowbase + (kb_) * 128 + krow + 64 * uu) * AB_IN + 1536 + 64 * h + 8 * kc8); \
        pvr[uu] = *(const u32x4*)(P0 + (rowbase + (kb_) * 128 + vs_) * AB_IN + 2048 + 64 * h + 8 * (vc8 + 4 * uu)); } } while (0)
#define SB_STAGE(Kd, Vd) do { _Pragma("unroll") for (int uu = 0; uu < 2; ++uu) { *(LAS u32x4*)((Kd) + (krow + 64 * uu) * 72 + 8 * kc8) = pkr[uu]; *(LAS u32x4*)((Vd) + vs_ * 72 + 8 * (vc8 + 4 * uu)) = pvr[uu]; } } while (0)
    SB_LOAD(qc);
    LDS_BAR();
    SB_STAGE(Kb2, Vb2);
    if (qc > 0) SB_LOAD(qc - 1);
    LDS_BAR();
    for (int kb = qc; kb >= 0; --kb) {
        const int cur = (qc - kb) & 1;
        LAS bf16_t* Ks = Kb2 + cur * (128 * 72); LAS bf16_t* Vl = Vb2 + cur * (128 * 72);
        const bool diag = (kb == qc);
        u32x2 pk[8];
#define SB0 __builtin_amdgcn_sched_barrier(0)
        bf16x8 kfr[2][2];
#define SK_LOAD(m_) do { kfr[(m_) & 1][0] = *(const LAS bf16x8*)(Ks + (16 * (m_) + fr) * 72 + 8 * fq); kfr[(m_) & 1][1] = *(const LAS bf16x8*)(Ks + (16 * (m_) + fr) * 72 + 32 + 8 * fq); } while (0)
        SK_LOAD(7);
#pragma unroll
        for (int m = 7; m >= 0; --m) {
            if (m > 0) SK_LOAD(m - 1);
            SB0;
            if (diag && m > w) { pk[m] = (u32x2){0u, 0u}; continue; }
            f32x4 z = (f32x4){0.f, 0.f, 0.f, 0.f};
            z = __builtin_amdgcn_mfma_f32_16x16x32_bf16(kfr[m & 1][0], qf0, z, 0, 0, 0);
            z = __builtin_amdgcn_mfma_f32_16x16x32_bf16(kfr[m & 1][1], qf1, z, 0, 0, 0);
            const int sb = kb * 128 + 16 * m + 4 * fq;
            float be[4], om[4];
#pragma unroll
            for (int r = 0; r < 4; ++r) { const bool ok = !diag || (sb + r < tq);
                const float e = __builtin_amdgcn_exp2f(-fabsf(z[r])), inv = __builtin_amdgcn_rcpf(1.f + e), ei = e * inv;
                be[r] = ok ? (z[r] >= 0.f ? inv : ei) : 0.f; om[r] = ok ? (z[r] >= 0.f ? ei : inv) : 1.f; }
            const float x3 = om[3], x2 = x3 * om[2], x1 = x2 * om[1], x0 = x1 * om[0];
            const float t1 = __shfl_xor(x0, 16), t2 = __shfl_xor(x0, 32), t3 = __shfl_xor(t1, 32);
            const float E = fq == 0 ? (t1 * t2 * t3) : fq == 1 ? (t2 * t3) : fq == 2 ? t1 : 1.f;
            const float base = R * E;
            f32x4 av;
            av[0] = be[0] * (x1 * base); av[1] = be[1] * (x2 * base); av[2] = be[2] * (x3 * base); av[3] = be[3] * base;
            pk[m] = pack4(av);
            R *= (x0 * t1) * (t2 * t3);
        }
#undef SK_LOAD
        { u32x4 vf[3][4];
#define SV_LOAD(j_) do { typedef short v4s __attribute__((ext_vector_type(4))); _Pragma("unroll") for (int n = 0; n < 4; ++n) { \
              const LAS bf16_t* p_ = Vl + (32 * (j_) + 4 * fq + (fr >> 2)) * 72 + 16 * n + 4 * (fr & 3);     \
              const v4s lo_ = __builtin_amdgcn_ds_read_tr16_b64_v4i16((LAS v4s*)p_), hi_ = __builtin_amdgcn_ds_read_tr16_b64_v4i16((LAS v4s*)(p_ + 16 * 72)); \
              const bf16x8 f_ = (bf16x8){lo_[0], lo_[1], lo_[2], lo_[3], hi_[0], hi_[1], hi_[2], hi_[3]}; vf[(j_) % 3][n] = __builtin_bit_cast(u32x4, f_); } } while (0)
          SV_LOAD(0); SV_LOAD(1); SB0;
#pragma unroll
          for (int j = 0; j < 4; ++j) { if (j + 2 < 4) SV_LOAD(j + 2);
              const u32x4 bw = (u32x4){pk[2 * j].x, pk[2 * j].y, pk[2 * j + 1].x, pk[2 * j + 1].y};
              const bf16x8 bfrag = __builtin_bit_cast(bf16x8, bw);
              SB0;
#pragma unroll
              for (int n = 0; n < 4; ++n) oacc[n] = __builtin_amdgcn_mfma_f32_16x16x32_bf16(__builtin_bit_cast(bf16x8, vf[j % 3][n]), bfrag, oacc[n], 0, 0, 0);
              SB0; }
#undef SV_LOAD
        }
#undef SB0
        if (kb > 0) { SB_STAGE(Kb2 + (cur ^ 1) * (128 * 72), Vb2 + (cur ^ 1) * (128 * 72)); if (kb > 1) SB_LOAD(kb - 2); }
        { const bool wall = __all(R < 1.17549435e-38f);   if (lane == 0) flags[8 * cur + w] = wall ? 1u : 0u; }
        LDS_BAR();
        { const u32x4 f0 = *(const LAS u32x4*)(flags + 8 * cur), f1 = *(const LAS u32x4*)(flags + 8 * cur + 4);
          if ((f0.x & f0.y & f0.z & f0.w & f1.x & f1.y & f1.z & f1.w) != 0u) break; }
    }
#undef SB_LOAD
#undef SB_STAGE
#pragma unroll
    for (int n = 0; n < 4; ++n) *(u32x2*)(MIX + (rowbase + tq) * DM + 512 + 64 * h + 16 * n + 4 * fq) = pack4(oacc[n]);
}

__device__ __forceinline__ void ret_unit(LAS unsigned char* lds, bf16_t* QKV, float* gn, int b, int h, int vs, bool commit, const float* s00p, const float* ss3, bool skel = false) {
    const int tid = threadIdx.x, lane = tid & 63, w = tid >> 6, fr = lane & 15, fq = lane >> 4;
    LAS bf16_t* Kb = (LAS bf16_t*)lds;
    LAS bf16_t* Ql = Kb + 2 * 64 * 264;
    LAS bf16_t* Vb = Ql + 64 * 264;
    LAS bf16_t* Pl = Vb + 2 * 64 * 136;
    LAS float* st = (LAS float*)(Pl + 64 * 72);
    const float l2g = __builtin_amdgcn_logf(1.0f - __builtin_amdgcn_exp2f(-5.0f - (float)h));
    const float cd = __builtin_amdgcn_exp2f(64.f * l2g);
    f32x4 state[16];
#pragma unroll
    for (int m = 0; m < 16; ++m) state[m] = (f32x4){0.f, 0.f, 0.f, 0.f};
    const float s00 = s00p[b * 4 + h] * rms_r(ss3[(size_t)b * SEQ]) * rms_r(ss3[(size_t)b * SEQ]) * 0.0625f;
    const int si = w & 3, ti0 = 2 * (w >> 2);
    u32x4 pq[4], pkv[4], pv[2];
    const int ls = tid & 63, lc8 = tid >> 6;
#define RET_LOAD(cc) do { const size_t tr_ = (size_t)b * SEQ + 64 * (cc) + ls; \
        _Pragma("unroll") for (int uu = 0; uu < 4; ++uu) { const bf16_t* rp = QKV + tr_ * RET_QKV + 256 * h + 8 * (lc8 + 8 * uu); pq[uu] = *(const u32x4*)rp; pkv[uu] = *(const u32x4*)(rp + 1024); } \
        _Pragma("unroll") for (int uu = 0; uu < 2; ++uu) pv[uu] = *(const u32x4*)(QKV + tr_ * RET_QKV + 2048 + 512 * h + 128 * vs + 8 * (lc8 + 8 * uu)); } while (0)
#define RET_STAGE(Kd, Vd) do { _Pragma("unroll") for (int uu = 0; uu < 4; ++uu) { const int c8 = lc8 + 8 * uu; *(LAS u32x4*)(Ql + ls * 264 + 8 * c8) = pq[uu]; *(LAS u32x4*)((Kd) + ls * 264 + 8 * c8) = pkv[uu]; } \
        _Pragma("unroll") for (int uu = 0; uu < 2; ++uu) { const int c8 = lc8 + 8 * uu; *(LAS u32x4*)((Vd) + ls * 136 + 8 * c8) = pv[uu]; } } while (0)
    RET_LOAD(0);
    LDS_BAR();
    RET_STAGE(Kb, Vb);
    RET_LOAD(1);
    if (tid < 128) st[tid] = 0.f;
    LDS_BAR();
    for (int c = 0; c < 32; ++c) {
        const size_t trow0 = (size_t)b * SEQ + 64 * c;
        LAS bf16_t* Kl = Kb + (c & 1) * (64 * 264); LAS bf16_t* Vl = Vb + (c & 1) * (64 * 136);
        LAS bf16_t* Kn = Kb + ((c & 1) ^ 1) * (64 * 264); LAS bf16_t* Vn = Vb + ((c & 1) ^ 1) * (64 * 136);
#define SB0 __builtin_amdgcn_sched_barrier(0)
#define TR_FRAG(dst, base, rs, col0, ks_) do { typedef short v4s __attribute__((ext_vector_type(4))); \
            const LAS bf16_t* p_ = (base) + (32 * (ks_) + 8 * fq + (fr >> 2)) * (rs) + (col0) + 4 * (fr & 3); \
            const v4s lo_ = __builtin_amdgcn_ds_read_tr16_b64_v4i16((LAS v4s*)p_), hi_ = __builtin_amdgcn_ds_read_tr16_b64_v4i16((LAS v4s*)(p_ + 4 * (rs))); \
            dst = (bf16x8){lo_[0], lo_[1], lo_[2], lo_[3], hi_[0], hi_[1], hi_[2], hi_[3]}; } while (0)
        f32x4 oacc[4];
#pragma unroll
        for (int n = 0; n < 4; ++n) oacc[n] = (f32x4){0.f, 0.f, 0.f, 0.f};
        if (!skel) {
        { f32x4 sv[2] = {(f32x4){0.f, 0.f, 0.f, 0.f}, (f32x4){0.f, 0.f, 0.f, 0.f}};
          bf16x8 ka[3], qb[3][2];
#define RA_LOAD(ks_) do { ka[(ks_) % 3] = *(const LAS bf16x8*)(Kl + (16 * si + fr) * 264 + 32 * (ks_) + 8 * fq); \
              _Pragma("unroll") for (int tt = 0; tt < 2; ++tt) qb[(ks_) % 3][tt] = *(const LAS bf16x8*)(Ql + (16 * (ti0 + tt) + fr) * 264 + 32 * (ks_) + 8 * fq); } while (0)
          RA_LOAD(0); RA_LOAD(1); SB0;
#pragma unroll
          for (int ks = 0; ks < 8; ++ks) { if (ks + 2 < 8) RA_LOAD(ks + 2); SB0;
#pragma unroll
              for (int tt = 0; tt < 2; ++tt) sv[tt] = __builtin_amdgcn_mfma_f32_16x16x32_bf16(ka[ks % 3], qb[ks % 3][tt], sv[tt], 0, 0, 0);
              SB0; }
#undef RA_LOAD
#pragma unroll
          for (int tt = 0; tt < 2; ++tt) { const int t = 16 * (ti0 + tt) + fr; f32x4 pvv;
#pragma unroll
              for (int r = 0; r < 4; ++r) { const int sidx = 16 * si + 4 * fq + r; pvv[r] = t >= sidx ? sv[tt][r] : 0.f; }
              if (c == 0 && t == 0 && si == 0 && fq == 0) pvv[0] = s00;
              *(LAS u32x2*)(Pl + t * 72 + 16 * si + 4 * fq) = pack4(pvv); } }
        { u32x4 qf[3][4];
#define RC_LOAD(kk_) do { _Pragma("unroll") for (int n = 0; n < 4; ++n) { const u32x2 lo = *(const LAS u32x2*)(Ql + (16 * n + fr) * 264 + 32 * (kk_) + 4 * fq), hi = *(const LAS u32x2*)(Ql + (16 * n + fr) * 264 + 32 * (kk_) + 16 + 4 * fq); \
              qf[(kk_) % 3][n] = (u32x4){lo.x, lo.y, hi.x, hi.y}; } } while (0)
          RC_LOAD(0); RC_LOAD(1); SB0;
#pragma unroll
          for (int kk = 0; kk < 8; ++kk) { if (kk + 2 < 8) RC_LOAD(kk + 2);
              const u32x2 s0 = pack4(state[2 * kk]), s1 = pack4(state[2 * kk + 1]);
              const u32x4 aw = (u32x4){s0.x, s0.y, s1.x, s1.y}; const bf16x8 afrag = __builtin_bit_cast(bf16x8, aw);
              SB0;
#pragma unroll
              for (int n = 0; n < 4; ++n) oacc[n] = __builtin_amdgcn_mfma_f32_16x16x32_bf16(afrag, __builtin_bit_cast(bf16x8, qf[kk % 3][n]), oacc[n], 0, 0, 0);
              SB0; }
#undef RC_LOAD
        }
#pragma unroll
        for (int n = 0; n < 4; ++n) oacc[n] = oacc[n] * cd;
        }
        LDS_BAR();
        if (c + 1 < 32) { RET_STAGE(Kn, Vn); if (c + 2 < 32) RET_LOAD(c + 2); }
        if (!skel) {
        bf16x8 vfrag[2];
        { bf16x8 pf[2][4];
#pragma unroll
          for (int ks = 0; ks < 2; ++ks) { TR_FRAG(vfrag[ks], Vl, 136, 16 * w, ks);
#pragma unroll
              for (int n = 0; n < 4; ++n) pf[ks][n] = *(const LAS bf16x8*)(Pl + (16 * n + fr) * 72 + 32 * ks + 8 * fq); }
          bf16x8 kf[3][2];
#define RD_LOAD(m_) do { _Pragma("unroll") for (int ks = 0; ks < 2; ++ks) TR_FRAG(kf[(m_) % 3][ks], Kl, 264, 16 * (m_), ks); } while (0)
          RD_LOAD(0); RD_LOAD(1); SB0;
#pragma unroll
          for (int ks = 0; ks < 2; ++ks)
#pragma unroll
              for (int n = 0; n < 4; ++n) oacc[n] = __builtin_amdgcn_mfma_f32_16x16x32_bf16(vfrag[ks], pf[ks][n], oacc[n], 0, 0, 0);
          SB0;
#pragma unroll
          for (int m = 0; m < 16; ++m) { if (m + 2 < 16) RD_LOAD(m + 2);
              state[m] = state[m] * cd; SB0;
#pragma unroll
              for (int ks = 0; ks < 2; ++ks) state[m] = __builtin_amdgcn_mfma_f32_16x16x32_bf16(kf[m % 3][ks], vfrag[ks], state[m], 0, 0, 0);
              SB0; }
#undef RD_LOAD
        }
        }
#undef SB0
#undef TR_FRAG
#pragma unroll
        for (int n = 0; n < 4; ++n) { const f32x4 o = oacc[n];
            float s1 = (o[0] + o[1]) + (o[2] + o[3]), s2 = (o[0] * o[0] + o[1] * o[1]) + (o[2] * o[2] + o[3] * o[3]);
            s1 += __shfl_xor(s1, 16); s1 += __shfl_xor(s1, 32); s2 += __shfl_xor(s2, 16); s2 += __shfl_xor(s2, 32);
            if (fq == 0) { atomicAdd((float*)(st + (16 * n + fr) * 2), s1); atomicAdd((float*)(st + (16 * n + fr) * 2 + 1), s2); }
            if (commit) *(u32x2*)(QKV + (trow0 + 16 * n + fr) * RET_QKV + 2048 + 512 * h + 128 * vs + 16 * w + 4 * fq) = pack4(o); }
        LDS_BAR();
        if (tid < 128) { if (commit) atomicAdd(gn + ((trow0 + (tid >> 1)) * 4 + h) * 2 + (tid & 1), st[tid]); st[tid] = 0.f; }
    }
#undef RET_STAGE
#undef RET_LOAD
}

__device__ __forceinline__ void conv_phase(const bf16_t* A, bf16_t* act, const float* cw, const float* cb) {
    const size_t gt = (size_t)blockIdx.x * NTHR + threadIdx.x, NT = (size_t)gridDim.x * NTHR;
    constexpr int CQ = DFF / 8, RI = 8;
    for (size_t it = gt; it < (size_t)(MH / RI) * CQ; it += NT) {
        const int cq = (int)(it % CQ), rb = (int)(it / CQ), j = 8 * cq, t0 = rb * RI;
        const bool hist = (t0 & (SEQ - 1)) != 0;
        u32x4 ga[RI + 2], ua[RI + 2];
        const u32x4 z4 = (u32x4){0u, 0u, 0u, 0u};
#pragma unroll
        for (int i = 0; i < RI + 2; ++i) {
            if (i < 2 && !hist) { ga[i] = z4; ua[i] = z4; }
            else { ga[i] = *(const u32x4*)(A + (size_t)(t0 - 2 + i) * UPN + j); ua[i] = *(const u32x4*)(A + (size_t)(t0 - 2 + i) * UPN + DFF + j); } }
        f32x4 wg[3][2], wu[3][2], bg[2], bu[2];
#pragma unroll
        for (int k = 0; k < 3; ++k) { wg[k][0] = *(const f32x4*)(cw + k * UPN + j); wg[k][1] = *(const f32x4*)(cw + k * UPN + j + 4); wu[k][0] = *(const f32x4*)(cw + k * UPN + DFF + j); wu[k][1] = *(const f32x4*)(cw + k * UPN + DFF + j + 4); }
        bg[0] = *(const f32x4*)(cb + j); bg[1] = *(const f32x4*)(cb + j + 4); bu[0] = *(const f32x4*)(cb + DFF + j); bu[1] = *(const f32x4*)(cb + DFF + j + 4);
#pragma unroll
        for (int i = 0; i < RI; ++i) {
            u32x2 o[2];
#pragma unroll
            for (int q = 0; q < 2; ++q) {
                const f32x4 g2 = unpack4(q == 0 ? (u32x2){ga[i].x, ga[i].y} : (u32x2){ga[i].z, ga[i].w}), g1 = unpack4(q == 0 ? (u32x2){ga[i + 1].x, ga[i + 1].y} : (u32x2){ga[i + 1].z, ga[i + 1].w}), g0 = unpack4(q == 0 ? (u32x2){ga[i + 2].x, ga[i + 2].y} : (u32x2){ga[i + 2].z, ga[i + 2].w});
                const f32x4 u2 = unpack4(q == 0 ? (u32x2){ua[i].x, ua[i].y} : (u32x2){ua[i].z, ua[i].w}), u1 = unpack4(q == 0 ? (u32x2){ua[i + 1].x, ua[i + 1].y} : (u32x2){ua[i + 1].z, ua[i + 1].w}), u0 = unpack4(q == 0 ? (u32x2){ua[i + 2].x, ua[i + 2].y} : (u32x2){ua[i + 2].z, ua[i + 2].w});
                const f32x4 cg = bg[q] + wg[0][q] * g2 + wg[1][q] * g1 + wg[2][q] * g0, cu = bu[q] + wu[0][q] * u2 + wu[1][q] * u1 + wu[2][q] * u0;
                o[q] = pack4(gelu4(cg) * cu); }
            *(u32x4*)(act + (size_t)(t0 + i) * DFF + j) = (u32x4){o[0].x, o[0].y, o[1].x, o[1].y};
        }
    }
}
__device__ __forceinline__ void s00_phase(LAS unsigned char* lds, float* s00p, const float* x3, const float* g1, const float* Wri) {
    const int tid = threadIdx.x; LAS float* red = (LAS float*)lds;
    for (int it = blockIdx.x; it < 256; it += gridDim.x) {
        const int b = it >> 4, h = (it >> 2) & 3, qd = it & 3, cq = tid & 31, ksl = tid >> 5;
        const int col = (cq >> 4) * 1024 + 256 * h + 64 * qd + 4 * (cq & 15);
        const float* xr = x3 + (size_t)b * SEQ * DM + 64 * ksl; const float* gr = g1 + 64 * ksl; const float* wp = Wri + (size_t)(64 * ksl) * RET_IN + col;
        f32x4 accd = (f32x4){0.f, 0.f, 0.f, 0.f};
#pragma unroll 16
        for (int k = 0; k < 64; ++k) accd = accd + *(const f32x4*)(wp + (size_t)k * RET_IN) * (xr[k] * gr[k]);
        __syncthreads();
        *(LAS f32x4*)(red + ksl * 128 + 4 * cq) = accd;
        __syncthreads();
        float cs = 0.f;
        if (tid < 128) {
#pragma unroll
            for (int j = 0; j < 16; ++j) cs += red[j * 128 + tid]; }
        __syncthreads();
        if (tid < 128) red[tid] = cs;
        __syncthreads();
        if (tid < 64) { const float pr = wave_sum(red[tid] * red[64 + tid]); if (tid == 0) atomicAdd(s00p + b * 4 + h, pr); }
    }
}
__device__ __forceinline__ void fixup_phase(bf16_t* act, const float* edge, const float* cw, const float* cb) {
    const size_t gt = (size_t)blockIdx.x * NTHR + threadIdx.x, NT = (size_t)gridDim.x * NTHR;
    constexpr int Q = DFF / 4;
    for (size_t it = gt; it < (size_t)512 * 2 * Q; it += NT) {
        const int jq = (int)(it % Q), gi = (int)(it / Q), i = gi & 1, grp = gi >> 1, j = 4 * jq;
        const bool hist = (grp & 31) != 0;
        const float* e0 = edge + (size_t)grp * 4 * UPN; const float* ep = e0 - 4 * UPN;
        const f32x4 zero = (f32x4){0.f, 0.f, 0.f, 0.f};
        f32x4 g2, g1, g0, u2, u1, u0;
        if (i == 0) { g2 = hist ? *(const f32x4*)(ep + 2 * UPN + j) : zero; u2 = hist ? *(const f32x4*)(ep + 2 * UPN + DFF + j) : zero;
                      g1 = hist ? *(const f32x4*)(ep + 3 * UPN + j) : zero; u1 = hist ? *(const f32x4*)(ep + 3 * UPN + DFF + j) : zero;
                      g0 = *(const f32x4*)(e0 + j); u0 = *(const f32x4*)(e0 + DFF + j); }
        else        { g2 = hist ? *(const f32x4*)(ep + 3 * UPN + j) : zero; u2 = hist ? *(const f32x4*)(ep + 3 * UPN + DFF + j) : zero;
                      g1 = *(const f32x4*)(e0 + j); u1 = *(const f32x4*)(e0 + DFF + j);
                      g0 = *(const f32x4*)(e0 + UPN + j); u0 = *(const f32x4*)(e0 + UPN + DFF + j); }
        const f32x4 cg = *(const f32x4*)(cb + j) + *(const f32x4*)(cw + j) * g2 + *(const f32x4*)(cw + UPN + j) * g1 + *(const f32x4*)(cw + 2 * UPN + j) * g0;
        const f32x4 cu = *(const f32x4*)(cb + DFF + j) + *(const f32x4*)(cw + DFF + j) * u2 + *(const f32x4*)(cw + UPN + DFF + j) * u1 + *(const f32x4*)(cw + 2 * UPN + DFF + j) * u0;
        *(u32x2*)(act + ((size_t)grp * 64 + i) * DFF + j) = pack4(gelu4(cg) * cu);
    }
}
__device__ __forceinline__ void final_phase(float* out, const float* ss, const float* g) {
    const int lane = threadIdx.x & 63, gw = blockIdx.x * NWAVES + (threadIdx.x >> 6), NGW = gridDim.x * NWAVES;
    f32x4 gv[4];
#pragma unroll
    for (int j = 0; j < 4; ++j) gv[j] = ((const f32x4*)g)[lane + 64 * j];
    for (int m0 = gw * 4; m0 < MT; m0 += NGW * 4) { f32x4 v[4][4]; float r[4];
#pragma unroll
        for (int q = 0; q < 4; ++q) { r[q] = ss[m0 + q];
#pragma unroll
            for (int j = 0; j < 4; ++j) v[q][j] = ((const f32x4*)(out + (size_t)(m0 + q) * DM))[lane + 64 * j]; }
#pragma unroll
        for (int q = 0; q < 4; ++q) { const float rr = rms_r(r[q]); f32x4* xr = (f32x4*)(out + (size_t)(m0 + q) * DM) + lane;
#pragma unroll
            for (int j = 0; j < 4; ++j) xr[64 * j] = v[q][j] * rr * gv[j]; } }
}

#define XB_TMO      128
#define XB_XCNT(j)  (256  + 64 * (j))
#define XB_XSUB(j)  (1280 + 64 * (j))
#define XB_XGEN(j)  (2304 + 64 * (j))
#define XB_TOP      3328
#define XB_TOPGEN   3392
#define XCD_BAR_WORDS 3456
#define XB_SPIN_CAP (1u << 20)
__device__ __forceinline__ unsigned xb_ld(unsigned* p)              { return __hip_atomic_load(p, __ATOMIC_RELAXED, __HIP_MEMORY_SCOPE_AGENT); }
__device__ __forceinline__ unsigned xb_add(unsigned* p, unsigned v) { return __hip_atomic_fetch_add(p, v, __ATOMIC_RELAXED, __HIP_MEMORY_SCOPE_AGENT); }
__device__ __forceinline__ unsigned xb_xcc_id() { return (unsigned)__builtin_amdgcn_s_getreg((3 << 11) | 20) & 0xFu; }
#define XB_SPIN(cond, bar) do { unsigned _sp = 0; while (cond) { __builtin_amdgcn_s_sleep(1); \
    if ((++_sp & 255u) == 0u) { if (xb_ld(&(bar)[XB_TMO])) break; if (_sp > XB_SPIN_CAP) { atomicAdd(&(bar)[XB_TMO], 1u); break; } } } } while (0)
struct XcdBarrier { unsigned* bar; unsigned x; volatile LAS unsigned* st; };
__device__ __forceinline__ XcdBarrier xcd_barrier_post(unsigned* bar, volatile LAS unsigned* st) {
    XcdBarrier b; b.bar = bar; b.x = xb_xcc_id(); b.st = st;
    if (threadIdx.x == 0) (void)xb_add(&bar[XB_XCNT(b.x)], 1u);
    return b;
}
__device__ __forceinline__ void xcd_barrier_complete(unsigned* bar, unsigned x, unsigned& nloc, unsigned& nx) {
    const unsigned G = gridDim.x * gridDim.y * gridDim.z;
    unsigned sum, cnt, mine, sp = 0u;
    for (;;) {
        sum = 0u; cnt = 0u; mine = 0u;
#pragma unroll
        for (unsigned j = 0; j < 16; ++j) { const unsigned c = xb_ld(&bar[XB_XCNT(j)]); sum += c; cnt += (c > 0u) ? 1u : 0u; mine = (j == x) ? c : mine; }
        if (sum == G) break;
        __builtin_amdgcn_s_sleep(1);
        if ((++sp & 255u) == 0u) { if (xb_ld(&bar[XB_TMO])) break; if (sp > XB_SPIN_CAP) { atomicAdd(&bar[XB_TMO], 1u); break; } }
    }
    nloc = mine > 0u ? mine : 1u; nx = cnt > 0u ? cnt : 1u;
}
__device__ __forceinline__ void xcd_barrier(const XcdBarrier& b) {
    asm volatile("s_waitcnt vmcnt(0)" ::: "memory");
    __syncthreads();
    if (threadIdx.x == 0) {
        unsigned* bar = b.bar;
        __builtin_amdgcn_s_waitcnt(0);
        unsigned nloc = b.st[0], nx = b.st[1];
        if (nloc == 0u) { xcd_barrier_complete(bar, b.x, nloc, nx); b.st[0] = nloc; b.st[1] = nx; }
        const unsigned old = xb_add(&bar[XB_XSUB(b.x)], 1u);
        const unsigned gen = old / nloc;
        if (old + 1u == (gen + 1u) * nloc) {
            __builtin_amdgcn_fence(__ATOMIC_RELEASE, "agent");
            asm volatile("s_waitcnt vmcnt(0)" ::: "memory");
            const unsigned og = xb_add(&bar[XB_TOP], 1u);
            const unsigned tg = og / nx;
            if (og + 1u == (tg + 1u) * nx) xb_add(&bar[XB_TOPGEN], 1u);
            else XB_SPIN(xb_ld(&bar[XB_TOPGEN]) == tg, bar);
            __builtin_amdgcn_fence(__ATOMIC_ACQUIRE, "agent");
            xb_add(&bar[XB_XGEN(b.x)], 1u);
            asm volatile("s_waitcnt vmcnt(0)" ::: "memory");
        } else {
            XB_SPIN(xb_ld(&bar[XB_XGEN(b.x)]) == gen, bar);
            __builtin_amdgcn_fence(__ATOMIC_ACQUIRE, "agent");
            asm volatile("s_waitcnt vmcnt(0)" ::: "memory");
        }
    }
    __syncthreads();
}

constexpr int N_PHASES = FUSED_FFN ? 17 : 21;
__global__ void __launch_bounds__(NTHR, 2) fwd_megakernel(Args a) {
    extern __shared__ __attribute__((aligned(16))) unsigned char lds_raw[];
    LAS unsigned char* lds = (LAS unsigned char*)lds_raw;
    cg::grid_group grid = cg::this_grid();
    const int G = gridDim.x, bx = blockIdx.x, lo = a.ph_lo, hi = a.ph_hi;
    volatile LAS unsigned* bst = (volatile LAS unsigned*)(lds + LDS_BYTES - 16);
    if (threadIdx.x == 0) { bst[0] = 0u; bst[1] = 0u; }
    __syncthreads();
    const XcdBarrier xbar = xcd_barrier_post((unsigned*)(a.ws + WS_BAR), bst);
    if (lo < 0) grid.sync();
    unsigned char* ws = a.ws;
    float* SS = (float*)(ws + WS_SS); float* PPSS = (float*)(ws + WS_PPSS); float* GN = (float*)(ws + WS_GN); float* S00 = (float*)(ws + WS_GN + 1 * MiB);
    const float* CS = (const float*)(ws + WS_ROPE); const float* SN = CS + SEQ * 128;
    bf16_t* WB = (bf16_t*)(ws + WS_W); bf16_t* XB = (bf16_t*)(ws + WS_XB); bf16_t* PB = (bf16_t*)(ws + WS_PB); bf16_t* MIX = (bf16_t*)(ws + WS_MIX);
    bf16_t* XB2 = (bf16_t*)(ws + WS_XB2); bf16_t* BIG = (bf16_t*)(ws + WS_BIG); bf16_t* ACT = (bf16_t*)(ws + WS_ACT); float* EDGE = (float*)(ws + WS_ACT);
#ifndef PHASE_MASK
#define PHASE_MASK 0xffffff
#endif
#define IN(k) (((PHASE_MASK >> (k)) & 1) && lo <= (k) && (k) < hi)
#ifndef DUP_MASK
#define DUP_MASK 0
#ifndef PROBE2_REPS
#define PROBE2_REPS 1
#endif

#ifdef PROBE_0
#define PROBE_P0 p0_prologue(a, lds);
#else
#define PROBE_P0
#endif


#endif
#define REP(k)
#define SEAM(k) do { if (IN(k) && IN((k) + 1)) xcd_barrier(xbar); } while (0)
#define GEMM_M(M_, EPI, Aptr, lda_, Bptr, ldb_, N_, K_, ...) do { pg8::Gemm g{Aptr, Bptr, lda_, ldb_, M_, N_, K_}; pg8::StaticOrder S; S.init(M_, N_, G, bx); pg8::EPI E{__VA_ARGS__}; pg8::gemm_phase<pg8::EPI>(lds, g, S, E); } while (0)
#define GEMM(EPI, ...) GEMM_M(MT, EPI, __VA_ARGS__)
#define GEMM_S(Gs_, cs_, EPI, Aptr, lda_, Bptr, ldb_, N_, K_, ...) do { pg8::Gemm g{Aptr, Bptr, lda_, ldb_, MT, N_, K_}; pg8::StaticOrder S; S.init(MT, N_, Gs_, cs_); pg8::EPI E{__VA_ARGS__}; pg8::gemm_phase<pg8::EPI>(lds, g, S, E); } while (0)

    if (IN(0)) { p0_prologue(a, lds); PROBE_P0 }
    SEAM(0);
    if (IN(1)) REP(1) GEMM(EpiProj0, XB, DM, WB + W_ABIN, DM, AB_IN, DM, BIG, SS);
    SEAM(1);
    if (IN(2)) for (int rep2_ = 0; rep2_ < PROBE2_REPS; ++rep2_) {
        for (int u = bx; u < 2048 + 1024; u += G) {
            if (u < 2048) { const int qc = 15 - (u >> 7), bh = u & 127; sb_unit(lds, BIG, MIX, bh >> 3, bh & 7, qc); }
            else { const int v = u - 2048; sg_unit(lds, BIG, MIX, a.in[I_SGLNG], a.in[I_SGLNB], a.in[I_SGW], a.in[I_SGB], v >> 6, (v >> 2) & 15, v & 3); }
        }
    }
    SEAM(2);
    if (IN(3)) GEMM(EpiRes, MIX, DM, WB + W_ABOUT, DM, DM, DM, a.in[I_X], a.out, XB, SS + 1 * MT);
#ifdef PROBE_P3
    if (IN(3)) GEMM(EpiRes, MIX, DM, WB + W_ABOUT, DM, DM, DM, a.in[I_X], a.out, XB, SS + 7 * MT);
#endif
    SEAM(3);
#if FUSED_FFN
#ifdef PROBE_F
#define PROBE_UPF(l) GEMM(EpiUp, XB, DM, WB + W_UP + (size_t)(l) * UPN * DM, DM, UPN, DM, BIG, EDGE, SS + ((l) == 0 ? 1 : 4) * MT, a.in[I_CONVW] + (size_t)(l) * 3 * UPN, a.in[I_CONVB] + (size_t)(l) * UPN);
#else
#define PROBE_UPF(l)
#endif
#define FFN_LAYER(l, pb) \
    if (IN(pb)) { \
        GEMM(EpiUp, XB, DM, WB + W_UP + (size_t)(l) * UPN * DM, DM, UPN, DM, BIG, EDGE, SS + ((l) == 0 ? 1 : 4) * MT, a.in[I_CONVW] + (size_t)(l) * 3 * UPN, a.in[I_CONVB] + (size_t)(l) * UPN); \
        PROBE_UPF(l) \
        GEMM(EpiPp, PB + (size_t)(l) * MT * PLE, PLE, WB + W_PP + (size_t)(l) * DM * PLE, PLE, DM, PLE, MIX, PPSS + (l) * MT); \
    } \
    SEAM(pb); \
    if (IN((pb) + 1)) fixup_phase(BIG, EDGE, a.in[I_CONVW] + (size_t)(l) * 3 * UPN, a.in[I_CONVB] + (size_t)(l) * UPN); \
    SEAM((pb) + 1); \
    if (IN((pb) + 2)) GEMM(EpiRes, BIG, DFF, WB + W_DOWN + (size_t)(l) * DM * DFF, DFF, DM, DFF, a.out, a.out, XB2, SS + ((l) == 0 ? 2 : 5) * MT); \
    SEAM((pb) + 2); \
    if (IN((pb) + 3)) GEMM(EpiPle, XB2, DM, WB + W_GATE + (size_t)(l) * DM * DM, DM, DM, DM, a.out, a.out, XB, SS + ((l) == 0 ? 2 : 5) * MT, SS + ((l) == 0 ? 3 : 6) * MT, MIX, PPSS + (l) * MT, a.in[I_POSTG] + (l) * DM); \
    SEAM((pb) + 3);
    constexpr int PH_L1 = 8, PH_F1 = 12, PH_FIN = 16;
#else
#define FFN_UP(l, hf) GEMM_M(MH, EpiPlain, XB + (size_t)(hf) * MH * DM, DM, WB + W_UP + (size_t)(l) * UPN * DM, DM, UPN, DM, BIG, SS + ((l) == 0 ? 1 : 4) * MT + (hf) * MH)
#define FFN_DOWN(l, hf) GEMM_M(MH, EpiRes, ACT, DFF, WB + W_DOWN + (size_t)(l) * DM * DFF, DFF, DM, DFF, a.out + (size_t)(hf) * MH * DM, a.out + (size_t)(hf) * MH * DM, XB + (size_t)(hf) * MH * DM, SS + ((l) == 0 ? 2 : 5) * MT + (hf) * MH)
#ifdef PROBE_CONV
#define FFN_CONV(l) do { conv_phase(BIG, ACT, a.in[I_CONVW] + (size_t)(l) * 3 * UPN, a.in[I_CONVB] + (size_t)(l) * UPN); conv_phase(BIG, ACT, a.in[I_CONVW] + (size_t)(l) * 3 * UPN, a.in[I_CONVB] + (size_t)(l) * UPN); } while (0)
#else
#define FFN_CONV(l) conv_phase(BIG, ACT, a.in[I_CONVW] + (size_t)(l) * 3 * UPN, a.in[I_CONVB] + (size_t)(l) * UPN)
#endif
#ifndef PROBE_UP
#define PROBE_UP(l)
#endif
#define FFN_LAYER(l, pb) \
    if (IN(pb)) { FFN_UP(l, 0); \
        if (G == 256) { if (bx >= 128) GEMM_S(128, bx - 128, EpiPp, PB + (size_t)(l) * MT * PLE, PLE, WB + W_PP + (size_t)(l) * DM * PLE, PLE, DM, PLE, MIX, PPSS + (l) * MT); } \
        else GEMM(EpiPp, PB + (size_t)(l) * MT * PLE, PLE, WB + W_PP + (size_t)(l) * DM * PLE, PLE, DM, PLE, MIX, PPSS + (l) * MT); } \
    SEAM(pb); \
    if (IN((pb) + 1)) FFN_CONV(l); \
    SEAM((pb) + 1); \
    if (IN((pb) + 2)) { FFN_DOWN(l, 0); FFN_UP(l, 1); } \
    SEAM((pb) + 2); \
    if (IN((pb) + 3)) FFN_CONV(l); \
    SEAM((pb) + 3); \
    if (IN((pb) + 4)) FFN_DOWN(l, 1); \
    SEAM((pb) + 4); \
    if (IN((pb) + 5)) GEMM(EpiPle, XB, DM, WB + W_GATE + (size_t)(l) * DM * DM, DM, DM, DM, a.out, a.out, XB, SS + ((l) == 0 ? 2 : 5) * MT, SS + ((l) == 0 ? 3 : 6) * MT, MIX, PPSS + (l) * MT, a.in[I_POSTG] + (l) * DM); \
    SEAM((pb) + 5);
    constexpr int PH_L1 = 10, PH_F1 = 14, PH_FIN = 20;
#endif

    FFN_LAYER(0, 4)
    if (IN(PH_L1)) { GEMM(EpiQkv, XB, DM, WB + W_RETIN, DM, RET_QKV, DM, BIG, SS + 3 * MT, CS, SN);
#ifdef PROBE_A
        GEMM(EpiQkv, XB, DM, WB + W_RETIN, DM, RET_QKV, DM, BIG, SS + 3 * MT, CS, SN);
#endif
 s00_phase(lds, S00, a.out, a.in[I_MIXG] + DM, a.in[I_RETIN]); }
    SEAM(PH_L1);
#ifdef PROBE_B
    if (IN(PH_L1 + 1)) { for (int u = bx; u < 256; u += G) ret_unit(lds, BIG, GN, u >> 4, (u >> 2) & 3, u & 3, lo < 0, S00, SS + 3 * MT, lo >= 0); }
#endif
    if (IN(PH_L1 + 1)) {
        for (int u = bx; u < 256; u += G) { const int xcd = u & 7, t = u >> 3, vs = t & 3, pair = 8 * xcd + (t >> 2);
            ret_unit(lds, BIG, GN, pair >> 2, pair & 3, vs, true, S00, SS + 3 * MT); } }
#ifdef EXTRA_SYNCS
    for (int es = 0; es < EXTRA_SYNCS; ++es) xcd_barrier(xbar);
#endif
    SEAM(PH_L1 + 1);
    if (IN(PH_L1 + 2)) GEMM(EpiGate, XB, DM, WB + W_RETIN + (size_t)RET_QKV * DM, DM, RET_V, DM, BIG, SS + 3 * MT, GN, a.in[I_RETGN]);
#ifdef PROBE_A
    if (IN(PH_L1 + 2)) GEMM(EpiGate, XB, DM, WB + W_RETIN + (size_t)RET_QKV * DM, DM, RET_V, DM, BIG, SS + 3 * MT, GN, a.in[I_RETGN]);
#endif
    SEAM(PH_L1 + 2);
    if (IN(PH_L1 + 3)) GEMM(EpiRes, BIG, RET_QKV, WB + W_RETOUT, RET_V, DM, RET_V, a.out, a.out, XB, SS + 4 * MT);
    SEAM(PH_L1 + 3);
    FFN_LAYER(1, PH_F1)
    if (IN(PH_FIN)) final_phase(a.out, SS + 6 * MT, a.in[I_FING]);
#undef IN
#undef SEAM
#undef GEMM
}

extern "C" void kernel_launch(void* const* d_in, const int* in_sizes, int n_in, void* d_out, int out_size, void* d_ws, size_t ws_size, hipStream_t stream) {
    static int grid = 0;
    if (grid == 0) {
        if (n_in != 22 || out_size != MT * DM || ws_size < WS_END) { fprintf(stderr, "kernel_launch: unexpected shapes (n_in %d out %d ws %zu)\n", n_in, out_size, ws_size); grid = -1; return; }
        int dev = 0, cus = 0, per_cu = 0;
        hipGetDevice(&dev); hipDeviceGetAttribute(&cus, hipDeviceAttributeMultiprocessorCount, dev);
        if (hipFuncSetAttribute((const void*)fwd_megakernel, hipFuncAttributeMaxDynamicSharedMemorySize, LDS_BYTES) != hipSuccess) { fprintf(stderr, "kernel_launch: hipFuncSetAttribute failed\n"); grid = -1; return; }
        if (hipOccupancyMaxActiveBlocksPerMultiprocessor(&per_cu, (const void*)fwd_megakernel, NTHR, LDS_BYTES) != hipSuccess || per_cu < 1) { fprintf(stderr, "kernel_launch: occupancy query says %d\n", per_cu); per_cu = 1; }
        (void)hipGetLastError();
        grid = cus;
        fprintf(stderr, "kernel_launch: grid %d (per_cu %d)\n", grid, per_cu);
    }
    if (grid < 0) return;
    if (hipMemsetAsync((char*)d_ws + WS_BAR, 0, 16384, stream) != hipSuccess) { fprintf(stderr, "kernel_launch: memset failed\n"); return; }
    Args a{};
    for (int i = 0; i < 22; ++i) a.in[i] = (const float*)d_in[i];
    a.out = (float*)d_out; a.ws = (unsigned char*)d_ws;
#if MK_N_LAUNCHES == 1
    a.ph_lo = 0; a.ph_hi = N_PHASES;
    void* args[] = {&a};
    hipError_t e = hipLaunchCooperativeKernel((const void*)fwd_megakernel, dim3(grid), dim3(NTHR), args, LDS_BYTES, stream);
    if (e != hipSuccess) fprintf(stderr, "kernel_launch: cooperative launch failed: %s\n", hipGetErrorString(e));
#else
    for (int p = 0; p < N_PHASES; ++p) { a.ph_lo = p; a.ph_hi = p + 1; hipLaunchKernelGGL(fwd_megakernel, dim3(grid), dim3(NTHR), LDS_BYTES, stream, a); }
#endif
}
```

```cpp
#include <hip/hip_runtime.h>
#include <hip/hip_cooperative_groups.h>
#include <cstdio>
#include <cstdint>
namespace cg = cooperative_groups;

#ifndef FUSED_FFN
#define FUSED_FFN 1
#endif
#ifndef MK_N_LAUNCHES
#define MK_N_LAUNCHES 1
#endif

#define LAS __attribute__((address_space(3)))
typedef unsigned short bf16_t;
typedef short bf16x8 __attribute__((ext_vector_type(8)));
typedef float f32x4 __attribute__((ext_vector_type(4)));
typedef float f32x2 __attribute__((ext_vector_type(2)));
typedef unsigned u32x4 __attribute__((ext_vector_type(4)));
typedef unsigned u32x2 __attribute__((ext_vector_type(2)));

constexpr int DM = 1024, BATCH = 16, SEQ = 2048, MT = BATCH * SEQ;
constexpr int PLE = 256, AB_IN = 2560, RET_QKV = 4096, RET_IN = 6144, RET_V = 2048, DFF = 2816, UPN = 5632;
constexpr int HDF = DFF / 2, MH = MT / 2;
constexpr float RMS_EPS = 1e-6f, LN_EPS = 1e-5f;
constexpr int NWAVES = 8, NTHR = 512;
constexpr int LDS_BYTES = 147456;

constexpr size_t MiB = 1u << 20;
constexpr size_t WS_SS = 0;
constexpr size_t WS_PPSS = 1 * MiB;
constexpr size_t WS_GN = 1 * MiB + 512 * 1024;
constexpr size_t WS_STAT_END = 3 * MiB;
constexpr size_t WS_ROPE = 3 * MiB;
constexpr size_t WS_W = 5 * MiB;
constexpr size_t WS_XB = 66 * MiB;
constexpr size_t WS_PB = 130 * MiB;
constexpr size_t WS_MIX = 162 * MiB;
constexpr size_t WS_BIG = 226 * MiB;
constexpr size_t WS_ACT = WS_BIG + 176 * MiB;
constexpr size_t WS_XB2 = 446 * MiB;
constexpr size_t WS_BAR = 512 * MiB - 16384;
constexpr size_t WS_END = 512 * MiB;
constexpr size_t W_ABIN = 0, W_ABOUT = W_ABIN + (size_t)AB_IN * DM, W_RETIN = W_ABOUT + (size_t)DM * DM, W_RETOUT = W_RETIN + (size_t)RET_IN * DM,
                 W_UP = W_RETOUT + (size_t)DM * RET_V, W_DOWN = W_UP + 2 * (size_t)UPN * DM, W_GATE = W_DOWN + 2 * (size_t)DM * DFF, W_PP = W_GATE + 2 * (size_t)DM * DM,
                 W_TOTAL = W_PP + 2 * (size_t)DM * PLE;
static_assert(W_TOTAL * 2 <= 61 * MiB, "weights fit");

__device__ __forceinline__ unsigned pk2(float lo, float hi);
__device__ __forceinline__ unsigned f2bf(float f) { return pk2(f, 0.f) & 0xffffu; }
__device__ __forceinline__ unsigned pk2(float lo, float hi) { unsigned r; asm("v_cvt_pk_bf16_f32 %0, %1, %2" : "=v"(r) : "v"(lo), "v"(hi)); return r; }
__device__ __forceinline__ float bflo(unsigned w) { return __builtin_bit_cast(float, w << 16); }
__device__ __forceinline__ float bfhi(unsigned w) { return __builtin_bit_cast(float, w & 0xffff0000u); }
__device__ __forceinline__ float wave_sum(float v) {
#pragma unroll
    for (int o = 1; o < 64; o <<= 1) v += __shfl_xor(v, o);
    return v;
}
__device__ __forceinline__ f32x2 gelu_pk(f32x2 v) {
    const f32x2 av = __builtin_elementwise_abs(v), d = av * 0.2316418882f + 1.0f;
    f32x2 t; t.x = __builtin_amdgcn_rcpf(d.x); t.y = __builtin_amdgcn_rcpf(d.y);
    f32x2 q = t * 0.5307027145f + (-0.7265760135f); q = q * t + 0.7107068705f; q = q * t + (-0.142248368f); q = q * t + 0.127414796f; q = q * t;
    const f32x2 s = (v * v) * (-0.72134752044f);
    f32x2 e; e.x = __builtin_amdgcn_exp2f(s.x); e.y = __builtin_amdgcn_exp2f(s.y);
    const f32x2 m = v * (q * e), r = v - m;
    f32x2 o; o.x = v.x < 0.f ? m.x : r.x; o.y = v.y < 0.f ? m.y : r.y; return o;
}
__device__ __forceinline__ f32x4 gelu4(f32x4 v) { const f32x2 a = gelu_pk((f32x2){v[0], v[1]}), b = gelu_pk((f32x2){v[2], v[3]}); return (f32x4){a.x, a.y, b.x, b.y}; }
__device__ __forceinline__ float fexp(float x) { return __builtin_amdgcn_exp2f(x * 1.44269504089f); }
__device__ __forceinline__ float softplus2_f(float z) { return fmaxf(z, 0.f) + __builtin_amdgcn_logf(1.f + __builtin_amdgcn_exp2f(-fabsf(z))); }
__device__ __forceinline__ float sigmoid_f(float z) { return __builtin_amdgcn_rcpf(1.f + fexp(-z)); }
__device__ __forceinline__ float rms_r(float ss) { return __builtin_amdgcn_rsqf(ss * (1.0f / DM) + RMS_EPS); }
__device__ __forceinline__ float dpp_ror1(float x) { return __builtin_bit_cast(float, __builtin_amdgcn_update_dpp(0, __builtin_bit_cast(int, x), 0x121, 0xF, 0xF, false)); }
__device__ __forceinline__ float dpp_ror2(float x) { return __builtin_bit_cast(float, __builtin_amdgcn_update_dpp(0, __builtin_bit_cast(int, x), 0x122, 0xF, 0xF, false)); }
__device__ __forceinline__ f32x4 ror1v(f32x4 v) { return (f32x4){dpp_ror1(v[0]), dpp_ror1(v[1]), dpp_ror1(v[2]), dpp_ror1(v[3])}; }
__device__ __forceinline__ f32x4 ror2v(f32x4 v) { return (f32x4){dpp_ror2(v[0]), dpp_ror2(v[1]), dpp_ror2(v[2]), dpp_ror2(v[3])}; }
__device__ __forceinline__ u32x2 pack4(f32x4 v) { return (u32x2){pk2(v[0], v[1]), pk2(v[2], v[3])}; }
__device__ __forceinline__ f32x4 unpack4(u32x2 w) { return (f32x4){bflo(w.x), bfhi(w.x), bflo(w.y), bfhi(w.y)}; }

namespace pg8 {
constexpr int BM = 256, BK = 64, HALF = 128, HTB = HALF * BK * 2, STAGE_BYTES = 8 * HTB, NXCD = 8, WGM = 8;
__device__ __forceinline__ int lds_byte(int r, int c) { const int st = (r >> 4) * 2 + (c >> 5), rr = r & 15, cc = c & 31, ob = rr * 64 + cc * 2; return st * 1024 + (ob ^ (((ob >> 9) & 1) << 5)); }
__device__ __forceinline__ void stage_rc(int b, int& R, int& C) { const int st = b / 1024, sb = b % 1024, swz = sb ^ (((sb >> 9) & 1) << 5); R = (st >> 1) * 16 + swz / 64; C = (st & 1) * 32 + (swz % 64) / 2; }
__device__ __forceinline__ int perm32(int rho) { const int n = rho >> 4, i = rho & 15; return 8 * (i >> 2) + 4 * n + (i & 3); }
struct Unit { int pm, pn; };
struct Gemm { const bf16_t* A; const bf16_t* Bt; int lda, ldb, M, N, K; };
struct StaticOrder {
    int nM, nN, nwg, G, c;
    __device__ void init(int M, int N, int G_, int c_) { nM = M / BM; nN = N / BM; nwg = nM * nN; G = G_; c = c_; }
    __device__ bool next(int i, Unit& u) const {
        const long L = (long)i * G + c; if (L >= nwg) return false;
        int wgid = (int)L; { const int q = nwg / NXCD, r = nwg % NXCD, xcd = wgid % NXCD, off = wgid / NXCD; wgid = (xcd < r ? xcd * (q + 1) : r * (q + 1) + (xcd - r) * q) + off; }
        const int nig = WGM * nN, gid = wgid / nig, fm = gid * WGM, gsz = (nM - fm) < WGM ? (nM - fm) : WGM;
        u.pm = fm + ((wgid % nig) % gsz); u.pn = (wgid % nig) / gsz; return true;
    }
};
template <class Epi>
__device__ __forceinline__ void gemm_phase(LAS unsigned char* lds, const Gemm g, const StaticOrder& S, const Epi& E) {
    const int tid = threadIdx.x, wid = __builtin_amdgcn_readfirstlane(tid >> 6), lane = tid & 63, wr = wid >> 2, wc = wid & 3, fr = lane & 15, fq = lane >> 4;
    const int K = g.K, nt = K / BK;
    unsigned voffA[2], voffB[2];
#pragma unroll
    for (int i = 0; i < 2; ++i) { int R, C; stage_rc(tid * 16 + i * 8192, R, C); const int Rb = (R & ~31) + perm32(R & 31);
        voffA[i] = (unsigned)(R * g.lda + C) * 2u; voffB[i] = (unsigned)(Rb * g.ldb + C) * 2u; }
    const size_t kstep = (size_t)(BK * 2);
    const size_t hstepA = (size_t)HALF * g.lda * 2, hstepB = (size_t)HALF * g.ldb * 2;
    const size_t tstepA = 2 * hstepA, tstepB = 2 * hstepB;
    const unsigned ldsw = (unsigned)wid * 1024u;
    const int aoff = lds_byte(wr * 64 + fr, fq * 8), boff = lds_byte(wc * 32 + fr, fq * 8);
#define PG8_SA(b, h) (((b) * 2 + (h)) * HTB)
#define PG8_SB(b, h) ((4 + (b) * 2 + (h)) * HTB)
#define PG8_STAGE(bufoff, gbase, voff) do { _Pragma("unroll") for (int _i = 0; _i < 2; ++_i) \
        __builtin_amdgcn_global_load_lds((const unsigned*)((const char*)(gbase) + (voff)[_i]), (LAS unsigned*)(lds + (bufoff) + ldsw + _i * 8192), 16, 0, 0); } while (0)
#define PG8_LDA(dst, b, h) do { _Pragma("unroll") for (int m = 0; m < 4; ++m) _Pragma("unroll") for (int k = 0; k < 2; ++k) dst[m][k] = *(const LAS bf16x8*)(lds + PG8_SA(b, h) + aoff + m * 2048 + k * 1024); } while (0)
#define PG8_LDB(dst, b, h) do { _Pragma("unroll") for (int n = 0; n < 2; ++n) _Pragma("unroll") for (int k = 0; k < 2; ++k) dst[n][k] = *(const LAS bf16x8*)(lds + PG8_SB(b, h) + boff + n * 2048 + k * 1024); } while (0)
#define PG8_MMA(ai, bj, At, Bt) do { __builtin_amdgcn_s_setprio(1); _Pragma("unroll") for (int m = 0; m < 4; ++m) _Pragma("unroll") for (int n = 0; n < 2; ++n) _Pragma("unroll") for (int k = 0; k < 2; ++k) \
        acc[ai][bj][m][n] = __builtin_amdgcn_mfma_f32_16x16x32_bf16(Bt[n][k], At[m][k], acc[ai][bj][m][n], 0, 0, 0); __builtin_amdgcn_s_setprio(0); } while (0)
#define PG8_WAIT_V(n) asm volatile("s_waitcnt vmcnt(" #n ")" ::: "memory")
#define PG8_WAIT_L(n) asm volatile("s_waitcnt lgkmcnt(" #n ")" ::: "memory")
#define PG8_BAR __builtin_amdgcn_s_barrier()
#define PG8_SCHED __builtin_amdgcn_sched_barrier(0)
    Unit cur, nxt; int ui = 0;
    if (!S.next(0, cur)) return;
    f32x4 acc[2][2][4][2];
#pragma unroll
    for (int a = 0; a < 2; ++a)
#pragma unroll
        for (int b = 0; b < 2; ++b)
#pragma unroll
            for (int m = 0; m < 4; ++m)
#pragma unroll
                for (int n = 0; n < 2; ++n) acc[a][b][m][n] = (f32x4){0.f, 0.f, 0.f, 0.f};
    bf16x8 At[4][2], B0[2][2], B1[2][2];
    const char* cA = (const char*)g.A + (size_t)cur.pm * tstepA; const char* cB = (const char*)g.Bt + (size_t)cur.pn * tstepB;
    PG8_STAGE(PG8_SB(0, 0), cB, voffB); PG8_STAGE(PG8_SB(0, 1), cB + hstepB, voffB); PG8_STAGE(PG8_SA(0, 0), cA, voffA); PG8_STAGE(PG8_SA(0, 1), cA + hstepA, voffA);
    if (wr == 1) PG8_BAR;
    PG8_WAIT_V(2); PG8_BAR;
    PG8_STAGE(PG8_SB(1, 0), cB + kstep, voffB); PG8_STAGE(PG8_SA(1, 0), cA + kstep, voffA); PG8_STAGE(PG8_SB(1, 1), cB + hstepB + kstep, voffB);
    PG8_WAIT_V(6); PG8_BAR;
    for (;;) {
        const bool has_next = S.next(ui + 1, nxt);
        const char* nA = has_next ? (const char*)g.A + (size_t)nxt.pm * tstepA : cA; const char* nB = has_next ? (const char*)g.Bt + (size_t)nxt.pn * tstepB : cB;
#pragma nounroll
        for (int t = 0; t < nt; t += 2) {
            const bool last = (t == nt - 2);
            const char* a1 = cA + (size_t)(t + 1) * kstep;
            const char* a2 = last ? nA : cA + (size_t)(t + 2) * kstep; const char* b2 = last ? nB : cB + (size_t)(t + 2) * kstep;
            const char* a3 = a2 + kstep; const char* b3 = b2 + kstep;
            PG8_LDB(B0, 0, 0); PG8_LDB(B1, 0, 1); PG8_SCHED; PG8_LDA(At, 0, 0); PG8_STAGE(PG8_SA(1, 1), a1 + hstepA, voffA);
            PG8_WAIT_V(8); PG8_WAIT_L(0); PG8_BAR; PG8_MMA(0, 0, At, B0); PG8_MMA(0, 1, At, B1); PG8_BAR; PG8_SCHED;
            PG8_LDA(At, 0, 1); PG8_STAGE(PG8_SB(0, 0), b2, voffB); PG8_STAGE(PG8_SB(0, 1), b2 + hstepB, voffB); PG8_STAGE(PG8_SA(0, 0), a2, voffA);
            PG8_WAIT_V(8); PG8_WAIT_L(0); PG8_BAR; PG8_MMA(1, 0, At, B0); PG8_MMA(1, 1, At, B1); PG8_BAR; PG8_SCHED;
            PG8_LDB(B0, 1, 0); PG8_LDB(B1, 1, 1); PG8_SCHED; PG8_LDA(At, 1, 0); PG8_STAGE(PG8_SA(0, 1), a2 + hstepA, voffA);
            PG8_WAIT_V(8); PG8_WAIT_L(0); PG8_BAR; PG8_MMA(0, 0, At, B0); PG8_MMA(0, 1, At, B1); PG8_BAR; PG8_SCHED;
            PG8_LDA(At, 1, 1); PG8_STAGE(PG8_SB(1, 0), b3, voffB); PG8_STAGE(PG8_SB(1, 1), b3 + hstepB, voffB); PG8_STAGE(PG8_SA(1, 0), a3, voffA);
            PG8_WAIT_V(8); PG8_WAIT_L(0); PG8_BAR; PG8_MMA(1, 0, At, B0); PG8_MMA(1, 1, At, B1); PG8_BAR; PG8_SCHED;
        }
        if (wr == 0) PG8_BAR;
        E(acc, cur, wr, wc, fr, fq);
        if (!has_next) break;
#pragma unroll
        for (int a = 0; a < 2; ++a)
#pragma unroll
            for (int b = 0; b < 2; ++b)
#pragma unroll
                for (int m = 0; m < 4; ++m)
#pragma unroll
                    for (int n = 0; n < 2; ++n) acc[a][b][m][n] = (f32x4){0.f, 0.f, 0.f, 0.f};
        cur = nxt; cA = nA; cB = nB; ++ui;
        if (wr == 1) PG8_BAR;
    }
    PG8_WAIT_V(0);
    PG8_BAR;
#undef PG8_SA
#undef PG8_SB
#undef PG8_STAGE
#undef PG8_LDA
#undef PG8_LDB
#undef PG8_MMA
#undef PG8_WAIT_V
#undef PG8_WAIT_L
#undef PG8_BAR
#undef PG8_SCHED
}

typedef f32x4 (&AccRef)[2][2][4][2];
#define EPI_SCHED __builtin_amdgcn_sched_barrier(0)
#define EPI_ROW(ai, m) (u.pm * 256 + (ai) * 128 + wr * 64 + (m) * 16 + fr)
#define EPI_COL(bj) (u.pn * 256 + (bj) * 128 + wc * 32 + 8 * fq)

#define EPI_IT_ROW(it) EPI_ROW((it) >> 2, (it) & 3)
#define EPI_LOAD_RR(ssp) float rr[8]; _Pragma("unroll") for (int it = 0; it < 8; ++it) rr[it] = (ssp)[EPI_IT_ROW(it)]; _Pragma("unroll") for (int it = 0; it < 8; ++it) rr[it] = rms_r(rr[it])
#define EPI_PACK8(v0, v1) (u32x4){pk2((v0)[0], (v0)[1]), pk2((v0)[2], (v0)[3]), pk2((v1)[0], (v1)[1]), pk2((v1)[2], (v1)[3])}
#define EPI_SQ8(x0, x1) (((x0)[0] * (x0)[0] + (x0)[1] * (x0)[1]) + ((x0)[2] * (x0)[2] + (x0)[3] * (x0)[3]) + ((x1)[0] * (x1)[0] + (x1)[1] * (x1)[1]) + ((x1)[2] * (x1)[2] + (x1)[3] * (x1)[3]))
struct EpiProj0 {
    bf16_t* O; const float* ss;
    __device__ __forceinline__ void operator()(AccRef acc, const Unit& u, int wr, int wc, int fr, int fq) const {
        asm volatile("" : "+v"(fr), "+v"(fq));
        const bool act = u.pn < 4;
        EPI_LOAD_RR(ss);
#pragma unroll
        for (int it = 0; it < 8; ++it) { const int ai = it >> 2, m = it & 3, row = EPI_IT_ROW(it);
#pragma unroll
            for (int bj = 0; bj < 2; ++bj) { f32x4 v0 = acc[ai][bj][m][0] * rr[it], v1 = acc[ai][bj][m][1] * rr[it];
                if (act) { v0 = gelu4(v0); v1 = gelu4(v1); }
                *(u32x4*)(O + (size_t)row * AB_IN + EPI_COL(bj)) = EPI_PACK8(v0, v1); } }
    }
};
struct EpiRes {
    const float* xin; float* xout; bf16_t* xb; float* ssout;
    __device__ __forceinline__ void operator()(AccRef acc, const Unit& u, int wr, int wc, int fr, int fq) const {
        asm volatile("" : "+v"(fr), "+v"(fq));
        f32x4 xc[2][2], xn[2][2];
#pragma unroll
        for (int bj = 0; bj < 2; ++bj) { const size_t p = (size_t)EPI_IT_ROW(0) * DM + EPI_COL(bj); xc[bj][0] = *(const f32x4*)(xin + p); xc[bj][1] = *(const f32x4*)(xin + p + 4); }
#pragma unroll
        for (int it = 0; it < 8; ++it) { const int ai = it >> 2, m = it & 3, row = EPI_IT_ROW(it);
            if (it + 1 < 8) {
#pragma unroll
                for (int bj = 0; bj < 2; ++bj) { const size_t p = (size_t)EPI_IT_ROW(it + 1) * DM + EPI_COL(bj); xn[bj][0] = *(const f32x4*)(xin + p); xn[bj][1] = *(const f32x4*)(xin + p + 4); } }
            float q = 0.f;
#pragma unroll
            for (int bj = 0; bj < 2; ++bj) { const size_t p = (size_t)row * DM + EPI_COL(bj);
                const f32x4 x0 = xc[bj][0] + acc[ai][bj][m][0], x1 = xc[bj][1] + acc[ai][bj][m][1];
                __builtin_nontemporal_store(x0, (f32x4*)(xout + p)); __builtin_nontemporal_store(x1, (f32x4*)(xout + p + 4));
                *(u32x4*)(xb + p) = EPI_PACK8(x0, x1);
                q += EPI_SQ8(x0, x1); }
            q += __shfl_xor(q, 16); q += __shfl_xor(q, 32);
            if (fq == 0) atomicAdd(ssout + row, q);
#pragma unroll
            for (int bj = 0; bj < 2; ++bj) { xc[bj][0] = xn[bj][0]; xc[bj][1] = xn[bj][1]; } }
    }
};
struct EpiPle {
    float* x; float* xo; bf16_t* xb; const float* ssin; float* ssout; const bf16_t* pp; const float* ppss; const float* postg;
    __device__ __forceinline__ void operator()(AccRef acc, const Unit& u, int wr, int wc, int fr, int fq) const {
        asm volatile("" : "+v"(fr), "+v"(fq));
        f32x4 pg[2][2];
#pragma unroll
        for (int bj = 0; bj < 2; ++bj) { pg[bj][0] = *(const f32x4*)(postg + EPI_COL(bj)); pg[bj][1] = *(const f32x4*)(postg + EPI_COL(bj) + 4); }
        f32x4 xc0, xc1, xn0, xn1; u32x4 pc, pn; float sc, sn_, qc, qn;
        { const size_t p = (size_t)EPI_IT_ROW(0) * DM + EPI_COL(0); xc0 = *(const f32x4*)(x + p); xc1 = *(const f32x4*)(x + p + 4); pc = *(const u32x4*)(pp + p); sc = ssin[EPI_IT_ROW(0)]; qc = ppss[EPI_IT_ROW(0)]; }
        float q = 0.f;
#pragma unroll
        for (int st = 0; st < 16; ++st) { const int it = st >> 1, bj = st & 1, ai = it >> 2, m = it & 3, row = EPI_IT_ROW(it);
            if (st + 1 < 16) { const int it1 = (st + 1) >> 1, bj1 = (st + 1) & 1; const size_t p = (size_t)EPI_IT_ROW(it1) * DM + EPI_COL(bj1);
                xn0 = *(const f32x4*)(x + p); xn1 = *(const f32x4*)(x + p + 4); pn = *(const u32x4*)(pp + p);
                if (bj1 == 0) { sn_ = ssin[EPI_IT_ROW(it1)]; qn = ppss[EPI_IT_ROW(it1)]; } }
            const float r = rms_r(sc), rp = rms_r(qc);
            const size_t p = (size_t)row * DM + EPI_COL(bj);
            const f32x4 p0 = (f32x4){bflo(pc.x), bfhi(pc.x), bflo(pc.y), bfhi(pc.y)}, p1 = (f32x4){bflo(pc.z), bfhi(pc.z), bflo(pc.w), bfhi(pc.w)};
            const f32x4 z0 = acc[ai][bj][m][0] * r, z1 = acc[ai][bj][m][1] * r;
            f32x4 g0, g1;
#pragma unroll
            for (int e = 0; e < 4; ++e) { g0[e] = sigmoid_f(z0[e]); g1[e] = sigmoid_f(z1[e]); }
            const f32x4 x0 = xc0 + g0 * (p0 * rp) * pg[bj][0], x1 = xc1 + g1 * (p1 * rp) * pg[bj][1];
            if (xo) { __builtin_nontemporal_store(x0, (f32x4*)(xo + p)); __builtin_nontemporal_store(x1, (f32x4*)(xo + p + 4)); }
            *(u32x4*)(xb + p) = EPI_PACK8(x0, x1);
            q += EPI_SQ8(x0, x1);
            if (bj == 1) { q += __shfl_xor(q, 16); q += __shfl_xor(q, 32); if (fq == 0) atomicAdd(ssout + row, q); q = 0.f; sc = sn_; qc = qn; }
            xc0 = xn0; xc1 = xn1; pc = pn; }
    }
};
struct EpiPp {
    bf16_t* O; float* ssout;
    __device__ __forceinline__ void operator()(AccRef acc, const Unit& u, int wr, int wc, int fr, int fq) const {
        asm volatile("" : "+v"(fr), "+v"(fq));
#pragma unroll
        for (int it = 0; it < 8; ++it) { const int ai = it >> 2, m = it & 3, row = EPI_IT_ROW(it); float q = 0.f;
#pragma unroll
            for (int bj = 0; bj < 2; ++bj) { const f32x4 x0 = acc[ai][bj][m][0], x1 = acc[ai][bj][m][1];
                *(u32x4*)(O + (size_t)row * DM + EPI_COL(bj)) = EPI_PACK8(x0, x1);
                q += EPI_SQ8(x0, x1); }
            q += __shfl_xor(q, 16); q += __shfl_xor(q, 32);
            if (fq == 0) atomicAdd(ssout + row, q); }
    }
};
struct EpiQkv {
    bf16_t* O; const float* ss; const float* cs; const float* sn;
    __device__ __forceinline__ void operator()(AccRef acc, const Unit& u, int wr, int wc, int fr, int fq) const {
        asm volatile("" : "+v"(fr), "+v"(fq));
        const bool rot = u.pn < 8; const int i0 = wc * 32 + 8 * fq;
        EPI_LOAD_RR(ss);
        if (rot) {
            const float l2g = __builtin_amdgcn_logf(1.0f - __builtin_amdgcn_exp2f(-5.0f - (float)(u.pn & 3))) * (u.pn < 4 ? 1.f : -1.f);
#pragma unroll
            for (int it = 0; it < 8; ++it) rr[it] *= __builtin_amdgcn_exp2f((float)(EPI_IT_ROW(it) & 63) * l2g); }
        f32x4 cc[2], sc[2], cn[2], sq[2];
        if (rot) {
#pragma unroll
            for (int n = 0; n < 2; ++n) { const int pos = EPI_IT_ROW(0) & (SEQ - 1); cc[n] = *(const f32x4*)(cs + pos * 128 + i0 + 4 * n); sc[n] = *(const f32x4*)(sn + pos * 128 + i0 + 4 * n); } }
#pragma unroll
        for (int it = 0; it < 8; ++it) { const int ai = it >> 2, m = it & 3, row = EPI_IT_ROW(it); const float r = rr[it];
            if (rot) {
                if (it + 1 < 8) {
#pragma unroll
                    for (int n = 0; n < 2; ++n) { const int pos = EPI_IT_ROW(it + 1) & (SEQ - 1); cn[n] = *(const f32x4*)(cs + pos * 128 + i0 + 4 * n); sq[n] = *(const f32x4*)(sn + pos * 128 + i0 + 4 * n); } }
#pragma unroll
                for (int n = 0; n < 2; ++n) { const f32x4 c = cc[n] * r, s_ = sc[n] * r;
                    const f32x4 x1 = acc[ai][0][m][n], x2 = acc[ai][1][m][n]; acc[ai][0][m][n] = x1 * c - x2 * s_; acc[ai][1][m][n] = x2 * c + x1 * s_; }
#pragma unroll
                for (int n = 0; n < 2; ++n) { cc[n] = cn[n]; sc[n] = sq[n]; } }
            else {
#pragma unroll
                for (int bj = 0; bj < 2; ++bj) { acc[ai][bj][m][0] = acc[ai][bj][m][0] * r; acc[ai][bj][m][1] = acc[ai][bj][m][1] * r; } }
#pragma unroll
            for (int bj = 0; bj < 2; ++bj) *(u32x4*)(O + (size_t)row * RET_QKV + EPI_COL(bj)) = EPI_PACK8(acc[ai][bj][m][0], acc[ai][bj][m][1]); }
    }
};
struct EpiGate {
    bf16_t* QKV; const float* ss; const float* gn; const float* gng;
    __device__ __forceinline__ void operator()(AccRef acc, const Unit& u, int wr, int wc, int fr, int fq) const {
        asm volatile("" : "+v"(fr), "+v"(fq));
        const int h = u.pn >> 1;
        f32x4 gg[2][2];
#pragma unroll
        for (int bj = 0; bj < 2; ++bj) { gg[bj][0] = *(const f32x4*)(gng + EPI_COL(bj)); gg[bj][1] = *(const f32x4*)(gng + EPI_COL(bj) + 4); }
        EPI_LOAD_RR(ss);
        f32x2 sts[8];
#pragma unroll
        for (int it = 0; it < 8; ++it) sts[it] = *(const f32x2*)(gn + ((size_t)EPI_IT_ROW(it) * 4 + h) * 2);
        u32x4 oc[2], on[2];
#pragma unroll
        for (int bj = 0; bj < 2; ++bj) oc[bj] = *(const u32x4*)(QKV + (size_t)EPI_IT_ROW(0) * RET_QKV + 2048 + EPI_COL(bj));
#pragma unroll
        for (int it = 0; it < 8; ++it) { const int ai = it >> 2, m = it & 3, row = EPI_IT_ROW(it); const float r = rr[it];
            if (it + 1 < 8) {
#pragma unroll
                for (int bj = 0; bj < 2; ++bj) on[bj] = *(const u32x4*)(QKV + (size_t)EPI_IT_ROW(it + 1) * RET_QKV + 2048 + EPI_COL(bj)); }
            const float mean = sts[it].x * (1.f / 512.f), var = fmaxf(sts[it].y * (1.f / 512.f) - mean * mean, 0.f), rstd = __builtin_amdgcn_rsqf(var + LN_EPS);
#pragma unroll
            for (int bj = 0; bj < 2; ++bj) { const int col = EPI_COL(bj);
                const u32x4 ow = oc[bj];
                const f32x4 o0 = (f32x4){bflo(ow.x), bfhi(ow.x), bflo(ow.y), bfhi(ow.y)}, o1 = (f32x4){bflo(ow.z), bfhi(ow.z), bflo(ow.w), bfhi(ow.w)};
                const f32x4 z0 = acc[ai][bj][m][0] * r, z1 = acc[ai][bj][m][1] * r;
                f32x4 g0, g1;
#pragma unroll
                for (int e = 0; e < 4; ++e) { g0[e] = z0[e] * sigmoid_f(z0[e]); g1[e] = z1[e] * sigmoid_f(z1[e]); }
                const f32x4 y0 = g0 * ((o0 - mean) * rstd) * gg[bj][0], y1 = g1 * ((o1 - mean) * rstd) * gg[bj][1];
                *(u32x4*)(QKV + (size_t)row * RET_QKV + col) = EPI_PACK8(y0, y1); }
#pragma unroll
            for (int bj = 0; bj < 2; ++bj) oc[bj] = on[bj]; }
    }
};
struct EpiPlain {
    bf16_t* O; const float* ss;
    __device__ __forceinline__ void operator()(AccRef acc, const Unit& u, int wr, int wc, int fr, int fq) const {
        asm volatile("" : "+v"(fr), "+v"(fq));
        EPI_LOAD_RR(ss);
#pragma unroll
        for (int it = 0; it < 8; ++it) { const int ai = it >> 2, m = it & 3, row = EPI_IT_ROW(it);
#pragma unroll
            for (int bj = 0; bj < 2; ++bj) { const f32x4 v0 = acc[ai][bj][m][0] * rr[it], v1 = acc[ai][bj][m][1] * rr[it];
                *(u32x4*)(O + (size_t)row * UPN + EPI_COL(bj)) = EPI_PACK8(v0, v1); } }
    }
};
struct EpiUp {
    bf16_t* act; float* edge; const float* ss; const float* cw; const float* cb;
    __device__ __forceinline__ void operator()(AccRef acc, const Unit& u, int wr, int wc, int fr, int fq) const {
        asm volatile("" : "+v"(fr), "+v"(fq));
        const int j0 = u.pn * 128 + wc * 32 + 8 * fq;
        u32x2 pa[2][2][4][2];
        { EPI_LOAD_RR(ss);
#pragma unroll
          for (int it = 0; it < 8; ++it)
#pragma unroll
              for (int bj = 0; bj < 2; ++bj)
#pragma unroll
                  for (int n = 0; n < 2; ++n) pa[it >> 2][bj][it & 3][n] = pack4(acc[it >> 2][bj][it & 3][n] * rr[it]); }
        __builtin_amdgcn_sched_barrier(0);
#pragma unroll
        for (int ai = 0; ai < 2; ++ai) {
            const int rowg = u.pm * 256 + ai * 128 + wr * 64; const int grp = rowg >> 6;
#pragma unroll
            for (int n = 0; n < 2; ++n) { const unsigned jn = (unsigned)(j0 + 4 * n);
                f32x4 cu[4];
                {
                    const f32x4 wu0 = *(const f32x4*)(cw + (DFF + jn)), wu1 = *(const f32x4*)(cw + (UPN + DFF + jn)), wu2 = *(const f32x4*)(cw + (2 * UPN + DFF + jn)), bu = *(const f32x4*)(cb + (DFF + jn));
                    f32x4 pu1 = (f32x4){0.f, 0.f, 0.f, 0.f}, pu2 = pu1;
#pragma unroll
                    for (int m = 0; m < 4; ++m) {
                        const f32x4 au = unpack4(pa[ai][1][m][n]);
                        const f32x4 ru1 = ror1v(au), ru2 = ror2v(au);
                        const f32x4 u1 = fr >= 1 ? ru1 : pu1, u2 = fr >= 2 ? ru2 : pu2;
                        if (m == 0 && fr < 2) *(f32x4*)(edge + (unsigned)((grp * 4 + fr) * UPN + DFF + jn)) = au;
                        if (m == 3 && fr >= 14) *(f32x4*)(edge + (unsigned)((grp * 4 + (fr - 12)) * UPN + DFF + jn)) = au;
                        cu[m] = bu + wu0 * u2 + wu1 * u1 + wu2 * au;
                        pu1 = ru1; pu2 = ru2; }
                }
                {
                    const f32x4 wg0 = *(const f32x4*)(cw + jn), wg1 = *(const f32x4*)(cw + (UPN + jn)), wg2 = *(const f32x4*)(cw + (2 * UPN + jn)), bg = *(const f32x4*)(cb + jn);
                    f32x4 pg1 = (f32x4){0.f, 0.f, 0.f, 0.f}, pg2 = pg1;
#pragma unroll
                    for (int m = 0; m < 4; ++m) { const int row = rowg + m * 16 + fr;
                        const f32x4 ag = unpack4(pa[ai][0][m][n]);
                        const f32x4 rg1 = ror1v(ag), rg2 = ror2v(ag);
                        const f32x4 g1 = fr >= 1 ? rg1 : pg1, g2 = fr >= 2 ? rg2 : pg2;
                        if (m == 0 && fr < 2) *(f32x4*)(edge + (unsigned)((grp * 4 + fr) * UPN + jn)) = ag;
                        if (m == 3 && fr >= 14) *(f32x4*)(edge + (unsigned)((grp * 4 + (fr - 12)) * UPN + jn)) = ag;
                        const f32x4 o = gelu4(bg + wg0 * g2 + wg1 * g1 + wg2 * ag) * cu[m];
                        if (!(m == 0 && fr < 2)) *(u32x2*)(act + (unsigned)(row * DFF + jn)) = pack4(o);
                        pg1 = rg1; pg2 = rg2; }
                }
            } }
    }
};
}

struct Args { const float* in[22]; float* out; unsigned char* ws; int ph_lo, ph_hi; };
enum { I_X = 0, I_P, I_MIXG, I_FFNG, I_PLEG, I_ABIN, I_SGLNG, I_SGLNB, I_SGW, I_SGB, I_ABOUT, I_RETIN, I_RETGN, I_RETOUT, I_UP, I_CONVW, I_CONVB, I_DOWN, I_PGATE, I_PPROJ, I_POSTG, I_FING };

struct TrD { const float* W; bf16_t* WT; const float* gk; int K, N, mode, sub; };
__device__ __forceinline__ TrD tr_decode(const Args& a, bf16_t* WB, int it) {
    constexpr int I0 = 16 * 80, I1 = 16 * 32, I2 = 16 * 192, I3 = 32 * 32, I4 = 16 * 176, I5 = 44 * 32, I6 = 16 * 32, I7 = 4 * 32;
    int r = it;
    if (r < I0) return TrD{a.in[I_ABIN], WB + W_ABIN, a.in[I_MIXG], DM, AB_IN, 1, r}; r -= I0;
    if (r < I1) return TrD{a.in[I_ABOUT], WB + W_ABOUT, nullptr, DM, DM, 0, r}; r -= I1;
    if (r < I2) return TrD{a.in[I_RETIN], WB + W_RETIN, a.in[I_MIXG] + DM, DM, RET_IN, 2, r}; r -= I2;
    if (r < I3) return TrD{a.in[I_RETOUT], WB + W_RETOUT, nullptr, RET_V, DM, 0, r}; r -= I3;
    if (r < 2 * I4) { const int l = r / I4; return TrD{a.in[I_UP] + (size_t)l * DM * UPN, WB + W_UP + (size_t)l * UPN * DM, a.in[I_FFNG] + l * DM, DM, UPN, 3, r % I4}; } r -= 2 * I4;
    if (r < 2 * I5) { const int l = r / I5; return TrD{a.in[I_DOWN] + (size_t)l * DFF * DM, WB + W_DOWN + (size_t)l * DM * DFF, nullptr, DFF, DM, 0, r % I5}; } r -= 2 * I5;
    if (r < 2 * I6) { const int l = r / I6; return TrD{a.in[I_PGATE] + (size_t)l * DM * DM, WB + W_GATE + (size_t)l * DM * DM, a.in[I_PLEG] + l * DM, DM, DM, 0, r % I6}; } r -= 2 * I6;
    { const int l = r / I7; return TrD{a.in[I_PPROJ] + (size_t)l * PLE * DM, WB + W_PP + (size_t)l * DM * PLE, nullptr, PLE, DM, 0, r % I7}; }
}
__device__ __forceinline__ void tr_load(const TrD& d, float (&v)[32], int lane) {
    const int nblk = d.N / 32, kb = d.sub / nblk, nb = d.sub % nblk, k0 = 64 * kb, n0 = 32 * nb;
#pragma unroll
    for (int i = 0; i < 32; ++i) { const int kk = 2 * i + (lane >> 5); v[i] = d.W[(size_t)(k0 + kk) * d.N + n0 + (lane & 31)]; }
    if (d.gk) {
#pragma unroll
        for (int i = 0; i < 32; ++i) v[i] *= d.gk[k0 + 2 * i + (lane >> 5)]; }
}
__device__ __forceinline__ void tr_stage(const TrD& d, const float (&v)[32], LAS float* scr, int lane) {
    const int nblk = d.N / 32, kb = d.sub / nblk, nb = d.sub % nblk, k0 = 64 * kb, n0 = 32 * nb;
#pragma unroll
    for (int i = 0; i < 32; ++i) scr[(2 * i + (lane >> 5)) * 33 + (lane & 31)] = v[i];
    asm volatile("s_waitcnt lgkmcnt(0)" ::: "memory");
    float sc = 1.f; int d0 = n0;
    if (d.mode == 1 && n0 >= 1024 && n0 < 1536) sc = 0.125f * 1.44269504089f;
    if (d.mode == 2 && n0 >= 1024 && n0 < 2048) sc = 0.0625f;
#if FUSED_FFN
    if (d.mode == 3) d0 = n0 < DFF ? (n0 / 128) * 256 + (n0 % 128) : ((n0 - DFF) / 128) * 256 + 128 + ((n0 - DFF) % 128);
#endif
    const int c = lane & 7;
#pragma unroll
    for (int j = 0; j < 4; ++j) { const int n = (lane >> 3) + 8 * j; const LAS float* s = scr + (8 * c) * 33 + n;
        u32x4 o; o.x = pk2(s[0 * 33] * sc, s[1 * 33] * sc); o.y = pk2(s[2 * 33] * sc, s[3 * 33] * sc); o.z = pk2(s[4 * 33] * sc, s[5 * 33] * sc); o.w = pk2(s[6 * 33] * sc, s[7 * 33] * sc);
        *(u32x4*)(d.WT + (size_t)(d0 + n) * d.K + k0 + 8 * c) = o; }
    asm volatile("s_waitcnt lgkmcnt(0)" ::: "memory");
}
__device__ __forceinline__ void p0_prologue(const Args& a, LAS unsigned char* lds) {
    const int tid = threadIdx.x, lane = tid & 63, wave = tid >> 6, G = gridDim.x;
    const int gw = blockIdx.x * NWAVES + wave, NGW = G * NWAVES;
    LAS float* scr = (LAS float*)(lds + wave * 17408);
    bf16_t* WB = (bf16_t*)(a.ws + WS_W);
    constexpr int NITEMS = 16 * 80 + 16 * 32 + 16 * 192 + 32 * 32 + 2 * (16 * 176) + 2 * (44 * 32) + 2 * (16 * 32) + 2 * (4 * 32);
    for (int it = gw; it < NITEMS; it += 2 * NGW) {
        const bool two = it + NGW < NITEMS;
        const TrD d0 = tr_decode(a, WB, it), d1 = tr_decode(a, WB, two ? it + NGW : it);
        float v0[32], v1[32];
        tr_load(d0, v0, lane); if (two) tr_load(d1, v1, lane);
        tr_stage(d0, v0, scr, lane); if (two) tr_stage(d1, v1, scr + 64 * 33, lane);
    }
    { const float* X = a.in[I_X]; bf16_t* XB = (bf16_t*)(a.ws + WS_XB); float* ss0 = (float*)(a.ws + WS_SS);
      for (int m0 = gw * 4; m0 < MT; m0 += NGW * 4) { f32x4 v[4][4];
#pragma unroll
          for (int rr = 0; rr < 4; ++rr) { const f32x4* xr = (const f32x4*)(X + (size_t)(m0 + rr) * DM) + lane;
#pragma unroll
              for (int j = 0; j < 4; ++j) v[rr][j] = xr[64 * j]; }
#pragma unroll
          for (int rr = 0; rr < 4; ++rr) { unsigned long long* o8 = (unsigned long long*)(XB + (size_t)(m0 + rr) * DM) + lane; float sq = 0.f;
#pragma unroll
              for (int j = 0; j < 4; ++j) { const f32x4 t = v[rr][j]; sq += (t.x * t.x + t.y * t.y) + (t.z * t.z + t.w * t.w); o8[64 * j] = (unsigned long long)pk2(t.x, t.y) | ((unsigned long long)pk2(t.z, t.w) << 32); }
              sq = wave_sum(sq); if (lane == 0) ss0[m0 + rr] = sq; } } }
    const size_t gt = (size_t)blockIdx.x * NTHR + tid, NT = (size_t)G * NTHR;
    { const float* P = a.in[I_P]; bf16_t* PB = (bf16_t*)(a.ws + WS_PB); constexpr size_t NG = (size_t)2 * MT * PLE / 8;
      for (size_t i0 = gt; i0 < NG; i0 += 4 * NT) { f32x4 v[4][2];
#pragma unroll
          for (int j = 0; j < 4; ++j) { const size_t i = i0 + j * NT; if (i < NG) { v[j][0] = *(const f32x4*)(P + i * 8); v[j][1] = *(const f32x4*)(P + i * 8 + 4); } }
#pragma unroll
          for (int j = 0; j < 4; ++j) { const size_t i = i0 + j * NT; if (i < NG) { u32x4 w; w.x = pk2(v[j][0].x, v[j][0].y); w.y = pk2(v[j][0].z, v[j][0].w); w.z = pk2(v[j][1].x, v[j][1].y); w.w = pk2(v[j][1].z, v[j][1].w); *(u32x4*)(PB + i * 8) = w; } } } }
    { f32x4* z = (f32x4*)(a.ws + WS_SS + (size_t)MT * 4); const size_t n = (WS_STAT_END - (size_t)MT * 4) / 16;
      for (size_t i = gt; i < n; i += NT) z[i] = (f32x4){0.f, 0.f, 0.f, 0.f}; }
    { float* cs = (float*)(a.ws + WS_ROPE); float* sn = cs + SEQ * 128;
      for (size_t i = gt; i < (size_t)SEQ * 128; i += NT) { const int pos = (int)(i >> 7), k = (int)(i & 127);
          const float inv = 1.0f / __builtin_amdgcn_exp2f((float)k * (1.0f / 128.0f) * 13.287712379549449f);
          const float ang = (float)pos * inv;
          double rev = (double)ang * 0.15915494309189535; rev -= floor(rev);
          const float fr = (float)rev;
          cs[i] = __builtin_amdgcn_cosf(fr); sn[i] = __builtin_amdgcn_sinf(fr); } }
}

#define LDS_BAR() do { asm volatile("s_waitcnt lgkmcnt(0)" ::: "memory"); __builtin_amdgcn_s_barrier(); asm volatile("" ::: "memory"); } while (0)
__device__ __forceinline__ void sg_unit(LAS unsigned char* lds, const bf16_t* P0, bf16_t* MIX, const float* lng, const float* lnb, const float* wsp, const float* bsp, int b, int nch, int g) {
    const int tid = threadIdx.x, lane = tid & 63, w = tid >> 6, fr = lane & 15, fq = lane >> 4;
    LAS bf16_t* vnl = (LAS bf16_t*)lds;
    LAS bf16_t* Wl = vnl + 128 * 136;
    const size_t rowbase = (size_t)b * SEQ + (size_t)nch * 128;
    __syncthreads();
    {
        const int s = tid >> 2, part = tid & 3;
        const bf16_t* vp = P0 + (rowbase + s) * AB_IN + 512 + 128 * g + 32 * part;
        float x[32]; float sum = 0.f;
#pragma unroll
        for (int j = 0; j < 4; ++j) { const u32x4 wv = *(const u32x4*)(vp + 8 * j);
            x[8 * j + 0] = bflo(wv.x); x[8 * j + 1] = bfhi(wv.x); x[8 * j + 2] = bflo(wv.y); x[8 * j + 3] = bfhi(wv.y);
            x[8 * j + 4] = bflo(wv.z); x[8 * j + 5] = bfhi(wv.z); x[8 * j + 6] = bflo(wv.w); x[8 * j + 7] = bfhi(wv.w); }
#pragma unroll
        for (int j = 0; j < 32; ++j) sum += x[j];
        sum += __shfl_xor(sum, 1); sum += __shfl_xor(sum, 2);
        const float mean = sum * (1.f / 128.f); float q = 0.f;
#pragma unroll
        for (int j = 0; j < 32; ++j) { x[j] -= mean; q += x[j] * x[j]; }
        q += __shfl_xor(q, 1); q += __shfl_xor(q, 2);
        const float rstd = __builtin_amdgcn_rsqf(q * (1.f / 128.f) + LN_EPS);
        const float* gp = lng + 128 * g + 32 * part; const float* bp = lnb + 128 * g + 32 * part;
#pragma unroll
        for (int j = 0; j < 4; ++j) { float y[8];
#pragma unroll
            for (int e = 0; e < 8; ++e) y[e] = x[8 * j + e] * rstd * gp[8 * j + e] + bp[8 * j + e];
            *(LAS u32x4*)(vnl + s * 136 + 32 * part + 8 * j) = (u32x4){pk2(y[0], y[1]), pk2(y[2], y[3]), pk2(y[4], y[5]), pk2(y[6], y[7])}; }
        const int t = tid >> 2, s0 = 32 * part; const float* wp = wsp + ((size_t)g * 128 + t) * 128 + s0;
#pragma unroll
        for (int j = 0; j < 4; ++j) { const f32x4 a0 = *(const f32x4*)(wp + 8 * j), a1 = *(const f32x4*)(wp + 8 * j + 4); const int sb = s0 + 8 * j;
            u32x4 o; o.x = pk2(sb + 0 <= t ? a0.x : 0.f, sb + 1 <= t ? a0.y : 0.f); o.y = pk2(sb + 2 <= t ? a0.z : 0.f, sb + 3 <= t ? a0.w : 0.f);
            o.z = pk2(sb + 4 <= t ? a1.x : 0.f, sb + 5 <= t ? a1.y : 0.f); o.w = pk2(sb + 6 <= t ? a1.z : 0.f, sb + 7 <= t ? a1.w : 0.f);
            *(LAS u32x4*)(Wl + t * 136 + sb) = o; }
    }
    __syncthreads();
    f32x4 acc[8];
#pragma unroll
    for (int mi = 0; mi < 8; ++mi) acc[mi] = (f32x4){0.f, 0.f, 0.f, 0.f};
    const int nks = ((16 * w + 15) >> 5) + 1;
    for (int ks = 0; ks < nks; ++ks) { const bf16x8 bfrag = *(const LAS bf16x8*)(Wl + (16 * w + fr) * 136 + 32 * ks + 8 * fq);
#pragma unroll
        for (int mi = 0; mi < 8; ++mi) { typedef short v4s __attribute__((ext_vector_type(4)));
            const LAS bf16_t* p_ = vnl + (32 * ks + 8 * fq + (fr >> 2)) * 136 + 16 * mi + 4 * (fr & 3);
            const v4s lo_ = __builtin_amdgcn_ds_read_tr16_b64_v4i16((LAS v4s*)p_), hi_ = __builtin_amdgcn_ds_read_tr16_b64_v4i16((LAS v4s*)(p_ + 4 * 136));
            const bf16x8 afrag = (bf16x8){lo_[0], lo_[1], lo_[2], lo_[3], hi_[0], hi_[1], hi_[2], hi_[3]};
            acc[mi] = __builtin_amdgcn_mfma_f32_16x16x32_bf16(afrag, bfrag, acc[mi], 0, 0, 0); } }
    const size_t trow = rowbase + 16 * w + fr; const float bias = bsp[g * 128 + 16 * w + fr];
#pragma unroll
    for (int mi = 0; mi < 8; ++mi) { const int c = 16 * mi + 4 * fq;
        const f32x4 uv = unpack4(*(const u32x2*)(P0 + trow * AB_IN + 128 * g + c));
        *(u32x2*)(MIX + trow * DM + 128 * g + c) = pack4((acc[mi] + bias) * uv); }
}
__device__ __forceinline__ void sb_unit(LAS unsigned char* lds, const bf16_t* P0, bf16_t* MIX, int b, int h, int qc) {
    const int tid = threadIdx.x, lane = tid & 63, w = tid >> 6, fr = lane & 15, fq = lane >> 4;
    LAS bf16_t* Kb2 = (LAS bf16_t*)lds;
    LAS bf16_t* Vb2 = Kb2 + 2 * 128 * 72;
    const size_t rowbase = (size_t)b * SEQ; const int q0 = qc * 128, tq = q0 + 16 * w + fr;
    const bf16_t* qp = P0 + (rowbase + tq) * AB_IN + 1024 + 64 * h + 8 * fq;
    const bf16x8 qf0 = *(const bf16x8*)qp, qf1 = *(const bf16x8*)(qp + 32);
    f32x4 oacc[4];
#pragma unroll
    for (int n = 0; n < 4; ++n) oacc[n] = (f32x4){0.f, 0.f, 0.f, 0.f};
    float R = 1.f;
    LAS unsigned* flags = (LAS unsigned*)(Vb2 + 2 * 128 * 72);
    u32x4 pkr[2], pvr[2];
    const int krow = tid >> 3, kc8 = tid & 7, vs_ = tid & 127, vc8 = tid >> 7;
#define SB_LOAD(kb_) do { _Pragma("unroll") for (int uu = 0; uu < 2; ++uu) { \
        pkr[uu] = *(const u32x4*)(P0 + (rowbase + (kb_) * 128 + krow + 64 * uu) * AB_IN + 1536 + 64 * h + 8 * kc8); \
        pvr[uu] = *(const u32x4*)(P0 + (rowbase + (kb_) * 128 + vs_) * AB_IN + 2048 + 64 * h + 8 * (vc8 + 4 * uu)); } } while (0)
#define SB_STAGE(Kd, Vd) do { _Pragma("unroll") for (int uu = 0; uu < 2; ++uu) { *(LAS u32x4*)((Kd) + (krow + 64 * uu) * 72 + 8 * kc8) = pkr[uu]; *(LAS u32x4*)((Vd) + vs_ * 72 + 8 * (vc8 + 4 * uu)) = pvr[uu]; } } while (0)
    SB_LOAD(qc);
    LDS_BAR();
    SB_STAGE(Kb2, Vb2);
    if (qc > 0) SB_LOAD(qc - 1);
    LDS_BAR();
    for (int kb = qc; kb >= 0; --kb) {
        const int cur = (qc - kb) & 1;
        LAS bf16_t* Ks = Kb2 + cur * (128 * 72); LAS bf16_t* Vl = Vb2 + cur * (128 * 72);
        const bool diag = (kb == qc);
        u32x2 pk[8];
#define SB0 __builtin_amdgcn_sched_barrier(0)
        bf16x8 kfr[2][2];
#define SK_LOAD(m_) do { kfr[(m_) & 1][0] = *(const LAS bf16x8*)(Ks + (16 * (m_) + fr) * 72 + 8 * fq); kfr[(m_) & 1][1] = *(const LAS bf16x8*)(Ks + (16 * (m_) + fr) * 72 + 32 + 8 * fq); } while (0)
        SK_LOAD(7);
#pragma unroll
        for (int m = 7; m >= 0; --m) {
            if (m > 0) SK_LOAD(m - 1);
            SB0;
            if (diag && m > w) { pk[m] = (u32x2){0u, 0u}; continue; }
            f32x4 z = (f32x4){0.f, 0.f, 0.f, 0.f};
            z = __builtin_amdgcn_mfma_f32_16x16x32_bf16(kfr[m & 1][0], qf0, z, 0, 0, 0);
            z = __builtin_amdgcn_mfma_f32_16x16x32_bf16(kfr[m & 1][1], qf1, z, 0, 0, 0);
            const int sb = kb * 128 + 16 * m + 4 * fq;
            float be[4], om[4];
#pragma unroll
            for (int r = 0; r < 4; ++r) { const bool ok = !diag || (sb + r < tq);
                const float e = __builtin_amdgcn_exp2f(-fabsf(z[r])), inv = __builtin_amdgcn_rcpf(1.f + e), ei = e * inv;
                be[r] = ok ? (z[r] >= 0.f ? inv : ei) : 0.f; om[r] = ok ? (z[r] >= 0.f ? ei : inv) : 1.f; }
            const float x3 = om[3], x2 = x3 * om[2], x1 = x2 * om[1], x0 = x1 * om[0];
            const float t1 = __shfl_xor(x0, 16), t2 = __shfl_xor(x0, 32), t3 = __shfl_xor(t1, 32);
            const float E = fq == 0 ? (t1 * t2 * t3) : fq == 1 ? (t2 * t3) : fq == 2 ? t1 : 1.f;
            const float base = R * E;
            f32x4 av;
            av[0] = be[0] * (x1 * base); av[1] = be[1] * (x2 * base); av[2] = be[2] * (x3 * base); av[3] = be[3] * base;
            pk[m] = pack4(av);
            R *= (x0 * t1) * (t2 * t3);
        }
#undef SK_LOAD
        { u32x4 vf[3][4];
#define SV_LOAD(j_) do { typedef short v4s __attribute__((ext_vector_type(4))); _Pragma("unroll") for (int n = 0; n < 4; ++n) { \
              const LAS bf16_t* p_ = Vl + (32 * (j_) + 4 * fq + (fr >> 2)) * 72 + 16 * n + 4 * (fr & 3);     \
              const v4s lo_ = __builtin_amdgcn_ds_read_tr16_b64_v4i16((LAS v4s*)p_), hi_ = __builtin_amdgcn_ds_read_tr16_b64_v4i16((LAS v4s*)(p_ + 16 * 72)); \
              const bf16x8 f_ = (bf16x8){lo_[0], lo_[1], lo_[2], lo_[3], hi_[0], hi_[1], hi_[2], hi_[3]}; vf[(j_) % 3][n] = __builtin_bit_cast(u32x4, f_); } } while (0)
          SV_LOAD(0); SV_LOAD(1); SB0;
#pragma unroll
          for (int j = 0; j < 4; ++j) { if (j + 2 < 4) SV_LOAD(j + 2);
              const u32x4 bw = (u32x4){pk[2 * j].x, pk[2 * j].y, pk[2 * j + 1].x, pk[2 * j + 1].y};
              const bf16x8 bfrag = __builtin_bit_cast(bf16x8, bw);
              SB0;
#pragma unroll
              for (int n = 0; n < 4; ++n) oacc[n] = __builtin_amdgcn_mfma_f32_16x16x32_bf16(__builtin_bit_cast(bf16x8, vf[j % 3][n]), bfrag, oacc[n], 0, 0, 0);
              SB0; }
#undef SV_LOAD
        }
#undef SB0
        if (kb > 0) { SB_STAGE(Kb2 + (cur ^ 1) * (128 * 72), Vb2 + (cur ^ 1) * (128 * 72)); if (kb > 1) SB_LOAD(kb - 2); }
        { const bool wall = __all(R < 1.17549435e-38f);   if (lane == 0) flags[8 * cur + w] = wall ? 1u : 0u; }
        LDS_BAR();
        { const u32x4 f0 = *(const LAS u32x4*)(flags + 8 * cur), f1 = *(const LAS u32x4*)(flags + 8 * cur + 4);
          if ((f0.x & f0.y & f0.z & f0.w & f1.x & f1.y & f1.z & f1.w) != 0u) break; }
    }
#undef SB_LOAD
#undef SB_STAGE
#pragma unroll
    for (int n = 0; n < 4; ++n) *(u32x2*)(MIX + (rowbase + tq) * DM + 512 + 64 * h + 16 * n + 4 * fq) = pack4(oacc[n]);
}

__device__ __forceinline__ void ret_unit(LAS unsigned char* lds, bf16_t* QKV, float* gn, int b, int h, int vs, bool commit, const float* s00p, const float* ss3, bool skel = false) {
    const int tid = threadIdx.x, lane = tid & 63, w = tid >> 6, fr = lane & 15, fq = lane >> 4;
    LAS bf16_t* Kb = (LAS bf16_t*)lds;
    LAS bf16_t* Ql = Kb + 2 * 64 * 264;
    LAS bf16_t* Vb = Ql + 64 * 264;
    LAS bf16_t* Pl = Vb + 2 * 64 * 136;
    LAS float* st = (LAS float*)(Pl + 64 * 72);
    const float l2g = __builtin_amdgcn_logf(1.0f - __builtin_amdgcn_exp2f(-5.0f - (float)h));
    const float cd = __builtin_amdgcn_exp2f(64.f * l2g);
    f32x4 state[16];
#pragma unroll
    for (int m = 0; m < 16; ++m) state[m] = (f32x4){0.f, 0.f, 0.f, 0.f};
    const float s00 = s00p[b * 4 + h] * rms_r(ss3[(size_t)b * SEQ]) * rms_r(ss3[(size_t)b * SEQ]) * 0.0625f;
    const int si = w & 3, ti0 = 2 * (w >> 2);
    u32x4 pq[4], pkv[4], pv[2];
    const int ls = tid & 63, lc8 = tid >> 6;
#define RET_LOAD(cc) do { const size_t tr_ = (size_t)b * SEQ + 64 * (cc) + ls; \
        _Pragma("unroll") for (int uu = 0; uu < 4; ++uu) { const bf16_t* rp = QKV + tr_ * RET_QKV + 256 * h + 8 * (lc8 + 8 * uu); pq[uu] = *(const u32x4*)rp; pkv[uu] = *(const u32x4*)(rp + 1024); } \
        _Pragma("unroll") for (int uu = 0; uu < 2; ++uu) pv[uu] = *(const u32x4*)(QKV + tr_ * RET_QKV + 2048 + 512 * h + 128 * vs + 8 * (lc8 + 8 * uu)); } while (0)
#define RET_STAGE(Kd, Vd) do { _Pragma("unroll") for (int uu = 0; uu < 4; ++uu) { const int c8 = lc8 + 8 * uu; *(LAS u32x4*)(Ql + ls * 264 + 8 * c8) = pq[uu]; *(LAS u32x4*)((Kd) + ls * 264 + 8 * c8) = pkv[uu]; } \
        _Pragma("unroll") for (int uu = 0; uu < 2; ++uu) { const int c8 = lc8 + 8 * uu; *(LAS u32x4*)((Vd) + ls * 136 + 8 * c8) = pv[uu]; } } while (0)
    RET_LOAD(0);
    LDS_BAR();
    RET_STAGE(Kb, Vb);
    RET_LOAD(1);
    if (tid < 128) st[tid] = 0.f;
    LDS_BAR();
    for (int c = 0; c < 32; ++c) {
        const size_t trow0 = (size_t)b * SEQ + 64 * c;
        LAS bf16_t* Kl = Kb + (c & 1) * (64 * 264); LAS bf16_t* Vl = Vb + (c & 1) * (64 * 136);
        LAS bf16_t* Kn = Kb + ((c & 1) ^ 1) * (64 * 264); LAS bf16_t* Vn = Vb + ((c & 1) ^ 1) * (64 * 136);
#define SB0 __builtin_amdgcn_sched_barrier(0)
#define TR_FRAG(dst, base, rs, col0, ks_) do { typedef short v4s __attribute__((ext_vector_type(4))); \
            const LAS bf16_t* p_ = (base) + (32 * (ks_) + 8 * fq + (fr >> 2)) * (rs) + (col0) + 4 * (fr & 3); \
            const v4s lo_ = __builtin_amdgcn_ds_read_tr16_b64_v4i16((LAS v4s*)p_), hi_ = __builtin_amdgcn_ds_read_tr16_b64_v4i16((LAS v4s*)(p_ + 4 * (rs))); \
            dst = (bf16x8){lo_[0], lo_[1], lo_[2], lo_[3], hi_[0], hi_[1], hi_[2], hi_[3]}; } while (0)
        f32x4 oacc[4];
#pragma unroll
        for (int n = 0; n < 4; ++n) oacc[n] = (f32x4){0.f, 0.f, 0.f, 0.f};
        if (!skel) {
        { f32x4 sv[2] = {(f32x4){0.f, 0.f, 0.f, 0.f}, (f32x4){0.f, 0.f, 0.f, 0.f}};
          bf16x8 ka[3], qb[3][2];
#define RA_LOAD(ks_) do { ka[(ks_) % 3] = *(const LAS bf16x8*)(Kl + (16 * si + fr) * 264 + 32 * (ks_) + 8 * fq); \
              _Pragma("unroll") for (int tt = 0; tt < 2; ++tt) qb[(ks_) % 3][tt] = *(const LAS bf16x8*)(Ql + (16 * (ti0 + tt) + fr) * 264 + 32 * (ks_) + 8 * fq); } while (0)
          RA_LOAD(0); RA_LOAD(1); SB0;
#pragma unroll
          for (int ks = 0; ks < 8; ++ks) { if (ks + 2 < 8) RA_LOAD(ks + 2); SB0;
#pragma unroll
              for (int tt = 0; tt < 2; ++tt) sv[tt] = __builtin_amdgcn_mfma_f32_16x16x32_bf16(ka[ks % 3], qb[ks % 3][tt], sv[tt], 0, 0, 0);
              SB0; }
#undef RA_LOAD
#pragma unroll
          for (int tt = 0; tt < 2; ++tt) { const int t = 16 * (ti0 + tt) + fr; f32x4 pvv;
#pragma unroll
              for (int r = 0; r < 4; ++r) { const int sidx = 16 * si + 4 * fq + r; pvv[r] = t >= sidx ? sv[tt][r] : 0.f; }
              if (c == 0 && t == 0 && si == 0 && fq == 0) pvv[0] = s00;
              *(LAS u32x2*)(Pl + t * 72 + 16 * si + 4 * fq) = pack4(pvv); } }
        { u32x4 qf[3][4];
#define RC_LOAD(kk_) do { _Pragma("unroll") for (int n = 0; n < 4; ++n) { const u32x2 lo = *(const LAS u32x2*)(Ql + (16 * n + fr) * 264 + 32 * (kk_) + 4 * fq), hi = *(const LAS u32x2*)(Ql + (16 * n + fr) * 264 + 32 * (kk_) + 16 + 4 * fq); \
              qf[(kk_) % 3][n] = (u32x4){lo.x, lo.y, hi.x, hi.y}; } } while (0)
          RC_LOAD(0); RC_LOAD(1); SB0;
#pragma unroll
          for (int kk = 0; kk < 8; ++kk) { if (kk + 2 < 8) RC_LOAD(kk + 2);
              const u32x2 s0 = pack4(state[2 * kk]), s1 = pack4(state[2 * kk + 1]);
              const u32x4 aw = (u32x4){s0.x, s0.y, s1.x, s1.y}; const bf16x8 afrag = __builtin_bit_cast(bf16x8, aw);
              SB0;
#pragma unroll
              for (int n = 0; n < 4; ++n) oacc[n] = __builtin_amdgcn_mfma_f32_16x16x32_bf16(afrag, __builtin_bit_cast(bf16x8, qf[kk % 3][n]), oacc[n], 0, 0, 0);
              SB0; }
#undef RC_LOAD
        }
#pragma unroll
        for (int n = 0; n < 4; ++n) oacc[n] = oacc[n] * cd;
        }
        LDS_BAR();
        if (c + 1 < 32) { RET_STAGE(Kn, Vn); if (c + 2 < 32) RET_LOAD(c + 2); }
        if (!skel) {
        bf16x8 vfrag[2];
        { bf16x8 pf[2][4];
#pragma unroll
          for (int ks = 0; ks < 2; ++ks) { TR_FRAG(vfrag[ks], Vl, 136, 16 * w, ks);
#pragma unroll
              for (int n = 0; n < 4; ++n) pf[ks][n] = *(const LAS bf16x8*)(Pl + (16 * n + fr) * 72 + 32 * ks + 8 * fq); }
          bf16x8 kf[3][2];
#define RD_LOAD(m_) do { _Pragma("unroll") for (int ks = 0; ks < 2; ++ks) TR_FRAG(kf[(m_) % 3][ks], Kl, 264, 16 * (m_), ks); } while (0)
          RD_LOAD(0); RD_LOAD(1); SB0;
#pragma unroll
          for (int ks = 0; ks < 2; ++ks)
#pragma unroll
              for (int n = 0; n < 4; ++n) oacc[n] = __builtin_amdgcn_mfma_f32_16x16x32_bf16(vfrag[ks], pf[ks][n], oacc[n], 0, 0, 0);
          SB0;
#pragma unroll
          for (int m = 0; m < 16; ++m) { if (m + 2 < 16) RD_LOAD(m + 2);
              state[m] = state[m] * cd; SB0;
#pragma unroll
              for (int ks = 0; ks < 2; ++ks) state[m] = __builtin_amdgcn_mfma_f32_16x16x32_bf16(kf[m % 3][ks], vfrag[ks], state[m], 0, 0, 0);
              SB0; }
#undef RD_LOAD
        }
        }
#undef SB0
#undef TR_FRAG
#pragma unroll
        for (int n = 0; n < 4; ++n) { const f32x4 o = oacc[n];
            float s1 = (o[0] + o[1]) + (o[2] + o[3]), s2 = (o[0] * o[0] + o[1] * o[1]) + (o[2] * o[2] + o[3] * o[3]);
            s1 += __shfl_xor(s1, 16); s1 += __shfl_xor(s1, 32); s2 += __shfl_xor(s2, 16); s2 += __shfl_xor(s2, 32);
            if (fq == 0) { atomicAdd((float*)(st + (16 * n + fr) * 2), s1); atomicAdd((float*)(st + (16 * n + fr) * 2 + 1), s2); }
            if (commit) *(u32x2*)(QKV + (trow0 + 16 * n + fr) * RET_QKV + 2048 + 512 * h + 128 * vs + 16 * w + 4 * fq) = pack4(o); }
        LDS_BAR();
        if (tid < 128) { if (commit) atomicAdd(gn + ((trow0 + (tid >> 1)) * 4 + h) * 2 + (tid & 1), st[tid]); st[tid] = 0.f; }
    }
#undef RET_STAGE
#undef RET_LOAD
}

__device__ __forceinline__ void conv_phase(const bf16_t* A, bf16_t* act, const float* cw, const float* cb) {
    const size_t gt = (size_t)blockIdx.x * NTHR + threadIdx.x, NT = (size_t)gridDim.x * NTHR;
    constexpr int CQ = DFF / 8, RI = 8;
    for (size_t it = gt; it < (size_t)(MH / RI) * CQ; it += NT) {
        const int cq = (int)(it % CQ), rb = (int)(it / CQ), j = 8 * cq, t0 = rb * RI;
        const bool hist = (t0 & (SEQ - 1)) != 0;
        u32x4 ga[RI + 2], ua[RI + 2];
        const u32x4 z4 = (u32x4){0u, 0u, 0u, 0u};
#pragma unroll
        for (int i = 0; i < RI + 2; ++i) {
            if (i < 2 && !hist) { ga[i] = z4; ua[i] = z4; }
            else { ga[i] = *(const u32x4*)(A + (size_t)(t0 - 2 + i) * UPN + j); ua[i] = *(const u32x4*)(A + (size_t)(t0 - 2 + i) * UPN + DFF + j); } }
        f32x4 wg[3][2], wu[3][2], bg[2], bu[2];
#pragma unroll
        for (int k = 0; k < 3; ++k) { wg[k][0] = *(const f32x4*)(cw + k * UPN + j); wg[k][1] = *(const f32x4*)(cw + k * UPN + j + 4); wu[k][0] = *(const f32x4*)(cw + k * UPN + DFF + j); wu[k][1] = *(const f32x4*)(cw + k * UPN + DFF + j + 4); }
        bg[0] = *(const f32x4*)(cb + j); bg[1] = *(const f32x4*)(cb + j + 4); bu[0] = *(const f32x4*)(cb + DFF + j); bu[1] = *(const f32x4*)(cb + DFF + j + 4);
#pragma unroll
        for (int i = 0; i < RI; ++i) {
            u32x2 o[2];
#pragma unroll
            for (int q = 0; q < 2; ++q) {
                const f32x4 g2 = unpack4(q == 0 ? (u32x2){ga[i].x, ga[i].y} : (u32x2){ga[i].z, ga[i].w}), g1 = unpack4(q == 0 ? (u32x2){ga[i + 1].x, ga[i + 1].y} : (u32x2){ga[i + 1].z, ga[i + 1].w}), g0 = unpack4(q == 0 ? (u32x2){ga[i + 2].x, ga[i + 2].y} : (u32x2){ga[i + 2].z, ga[i + 2].w});
                const f32x4 u2 = unpack4(q == 0 ? (u32x2){ua[i].x, ua[i].y} : (u32x2){ua[i].z, ua[i].w}), u1 = unpack4(q == 0 ? (u32x2){ua[i + 1].x, ua[i + 1].y} : (u32x2){ua[i + 1].z, ua[i + 1].w}), u0 = unpack4(q == 0 ? (u32x2){ua[i + 2].x, ua[i + 2].y} : (u32x2){ua[i + 2].z, ua[i + 2].w});
                const f32x4 cg = bg[q] + wg[0][q] * g2 + wg[1][q] * g1 + wg[2][q] * g0, cu = bu[q] + wu[0][q] * u2 + wu[1][q] * u1 + wu[2][q] * u0;
                o[q] = pack4(gelu4(cg) * cu); }
            *(u32x4*)(act + (size_t)(t0 + i) * DFF + j) = (u32x4){o[0].x, o[0].y, o[1].x, o[1].y};
        }
    }
}
__device__ __forceinline__ void s00_phase(LAS unsigned char* lds, float* s00p, const float* x3, const float* g1, const float* Wri) {
    const int tid = threadIdx.x; LAS float* red = (LAS float*)lds;
    for (int it = blockIdx.x; it < 256; it += gridDim.x) {
        const int b = it >> 4, h = (it >> 2) & 3, qd = it & 3, cq = tid & 31, ksl = tid >> 5;
        const int col = (cq >> 4) * 1024 + 256 * h + 64 * qd + 4 * (cq & 15);
        const float* xr = x3 + (size_t)b * SEQ * DM + 64 * ksl; const float* gr = g1 + 64 * ksl; const float* wp = Wri + (size_t)(64 * ksl) * RET_IN + col;
        f32x4 accd = (f32x4){0.f, 0.f, 0.f, 0.f};
#pragma unroll 16
        for (int k = 0; k < 64; ++k) accd = accd + *(const f32x4*)(wp + (size_t)k * RET_IN) * (xr[k] * gr[k]);
        __syncthreads();
        *(LAS f32x4*)(red + ksl * 128 + 4 * cq) = accd;
        __syncthreads();
        float cs = 0.f;
        if (tid < 128) {
#pragma unroll
            for (int j = 0; j < 16; ++j) cs += red[j * 128 + tid]; }
        __syncthreads();
        if (tid < 128) red[tid] = cs;
        __syncthreads();
        if (tid < 64) { const float pr = wave_sum(red[tid] * red[64 + tid]); if (tid == 0) atomicAdd(s00p + b * 4 + h, pr); }
    }
}
__device__ __forceinline__ void fixup_phase(bf16_t* act, const float* edge, const float* cw, const float* cb) {
    const size_t gt = (size_t)blockIdx.x * NTHR + threadIdx.x, NT = (size_t)gridDim.x * NTHR;
    constexpr int Q = DFF / 4;
    for (size_t it = gt; it < (size_t)512 * 2 * Q; it += NT) {
        const int jq = (int)(it % Q), gi = (int)(it / Q), i = gi & 1, grp = gi >> 1, j = 4 * jq;
        const bool hist = (grp & 31) != 0;
        const float* e0 = edge + (size_t)grp * 4 * UPN; const float* ep = e0 - 4 * UPN;
        const f32x4 zero = (f32x4){0.f, 0.f, 0.f, 0.f};
        f32x4 g2, g1, g0, u2, u1, u0;
        if (i == 0) { g2 = hist ? *(const f32x4*)(ep + 2 * UPN + j) : zero; u2 = hist ? *(const f32x4*)(ep + 2 * UPN + DFF + j) : zero;
                      g1 = hist ? *(const f32x4*)(ep + 3 * UPN + j) : zero; u1 = hist ? *(const f32x4*)(ep + 3 * UPN + DFF + j) : zero;
                      g0 = *(const f32x4*)(e0 + j); u0 = *(const f32x4*)(e0 + DFF + j); }
        else        { g2 = hist ? *(const f32x4*)(ep + 3 * UPN + j) : zero; u2 = hist ? *(const f32x4*)(ep + 3 * UPN + DFF + j) : zero;
                      g1 = *(const f32x4*)(e0 + j); u1 = *(const f32x4*)(e0 + DFF + j);
                      g0 = *(const f32x4*)(e0 + UPN + j); u0 = *(const f32x4*)(e0 + UPN + DFF + j); }
        const f32x4 cg = *(const f32x4*)(cb + j) + *(const f32x4*)(cw + j) * g2 + *(const f32x4*)(cw + UPN + j) * g1 + *(const f32x4*)(cw + 2 * UPN + j) * g0;
        const f32x4 cu = *(const f32x4*)(cb + DFF + j) + *(const f32x4*)(cw + DFF + j) * u2 + *(const f32x4*)(cw + UPN + DFF + j) * u1 + *(const f32x4*)(cw + 2 * UPN + DFF + j) * u0;
        *(u32x2*)(act + ((size_t)grp * 64 + i) * DFF + j) = pack4(gelu4(cg) * cu);
    }
}
__device__ __forceinline__ void final_phase(float* out, const float* ss, const float* g) {
    const int lane = threadIdx.x & 63, gw = blockIdx.x * NWAVES + (threadIdx.x >> 6), NGW = gridDim.x * NWAVES;
    f32x4 gv[4];
#pragma unroll
    for (int j = 0; j < 4; ++j) gv[j] = ((const f32x4*)g)[lane + 64 * j];
    for (int m0 = gw * 4; m0 < MT; m0 += NGW * 4) { f32x4 v[4][4]; float r[4];
#pragma unroll
        for (int q = 0; q < 4; ++q) { r[q] = ss[m0 + q];
#pragma unroll
            for (int j = 0; j < 4; ++j) v[q][j] = ((const f32x4*)(out + (size_t)(m0 + q) * DM))[lane + 64 * j]; }
#pragma unroll
        for (int q = 0; q < 4; ++q) { const float rr = rms_r(r[q]); f32x4* xr = (f32x4*)(out + (size_t)(m0 + q) * DM) + lane;
#pragma unroll
            for (int j = 0; j < 4; ++j) __builtin_nontemporal_store(v[q][j] * rr * gv[j], xr + 64 * j); } }
}

#define XB_TMO      128
#define XB_XCNT(j)  (256  + 64 * (j))
#define XB_XSUB(j)  (1280 + 64 * (j))
#define XB_XGEN(j)  (2304 + 64 * (j))
#define XB_TOP      3328
#define XB_TOPGEN   3392
#define XCD_BAR_WORDS 3456
#define XB_SPIN_CAP (1u << 20)
__device__ __forceinline__ unsigned xb_ld(unsigned* p)              { return __hip_atomic_load(p, __ATOMIC_RELAXED, __HIP_MEMORY_SCOPE_AGENT); }
__device__ __forceinline__ unsigned xb_add(unsigned* p, unsigned v) { return __hip_atomic_fetch_add(p, v, __ATOMIC_RELAXED, __HIP_MEMORY_SCOPE_AGENT); }
__device__ __forceinline__ unsigned xb_xcc_id() { return (unsigned)__builtin_amdgcn_s_getreg((3 << 11) | 20) & 0xFu; }
#define XB_SPIN(cond, bar) do { unsigned _sp = 0; while (cond) { __builtin_amdgcn_s_sleep(1); \
    if ((++_sp & 255u) == 0u) { if (xb_ld(&(bar)[XB_TMO])) break; if (_sp > XB_SPIN_CAP) { atomicAdd(&(bar)[XB_TMO], 1u); break; } } } } while (0)
struct XcdBarrier { unsigned* bar; unsigned x; volatile LAS unsigned* st; };
__device__ __forceinline__ XcdBarrier xcd_barrier_post(unsigned* bar, volatile LAS unsigned* st) {
    XcdBarrier b; b.bar = bar; b.x = xb_xcc_id(); b.st = st;
    if (threadIdx.x == 0) (void)xb_add(&bar[XB_XCNT(b.x)], 1u);
    return b;
}
__device__ __forceinline__ void xcd_barrier_complete(unsigned* bar, unsigned x, unsigned& nloc, unsigned& nx) {
    const unsigned G = gridDim.x * gridDim.y * gridDim.z;
    unsigned sum, cnt, mine, sp = 0u;
    for (;;) {
        sum = 0u; cnt = 0u; mine = 0u;
#pragma unroll
        for (unsigned j = 0; j < 16; ++j) { const unsigned c = xb_ld(&bar[XB_XCNT(j)]); sum += c; cnt += (c > 0u) ? 1u : 0u; mine = (j == x) ? c : mine; }
        if (sum == G) break;
        __builtin_amdgcn_s_sleep(1);
        if ((++sp & 255u) == 0u) { if (xb_ld(&bar[XB_TMO])) break; if (sp > XB_SPIN_CAP) { atomicAdd(&bar[XB_TMO], 1u); break; } }
    }
    nloc = mine > 0u ? mine : 1u; nx = cnt > 0u ? cnt : 1u;
}
__device__ __forceinline__ void xcd_barrier(const XcdBarrier& b) {
    asm volatile("s_waitcnt vmcnt(0)" ::: "memory");
    __syncthreads();
    if (threadIdx.x == 0) {
        unsigned* bar = b.bar;
        __builtin_amdgcn_s_waitcnt(0);
        unsigned nloc = b.st[0], nx = b.st[1];
        if (nloc == 0u) { xcd_barrier_complete(bar, b.x, nloc, nx); b.st[0] = nloc; b.st[1] = nx; }
        const unsigned old = xb_add(&bar[XB_XSUB(b.x)], 1u);
        const unsigned gen = old / nloc;
        if (old + 1u == (gen + 1u) * nloc) {
            __builtin_amdgcn_fence(__ATOMIC_RELEASE, "agent");
            asm volatile("s_waitcnt vmcnt(0)" ::: "memory");
            const unsigned og = xb_add(&bar[XB_TOP], 1u);
            const unsigned tg = og / nx;
            if (og + 1u == (tg + 1u) * nx) xb_add(&bar[XB_TOPGEN], 1u);
            else XB_SPIN(xb_ld(&bar[XB_TOPGEN]) == tg, bar);
            __builtin_amdgcn_fence(__ATOMIC_ACQUIRE, "agent");
            xb_add(&bar[XB_XGEN(b.x)], 1u);
            asm volatile("s_waitcnt vmcnt(0)" ::: "memory");
        } else {
            XB_SPIN(xb_ld(&bar[XB_XGEN(b.x)]) == gen, bar);
            __builtin_amdgcn_fence(__ATOMIC_ACQUIRE, "agent");
            asm volatile("s_waitcnt vmcnt(0)" ::: "memory");
        }
    }
    __syncthreads();
}

constexpr int N_PHASES = FUSED_FFN ? 17 : 21;
__global__ void __launch_bounds__(NTHR, 2) fwd_megakernel(Args a) {
    extern __shared__ __attribute__((aligned(16))) unsigned char lds_raw[];
    LAS unsigned char* lds = (LAS unsigned char*)lds_raw;
    cg::grid_group grid = cg::this_grid();
    const int G = gridDim.x, bx = blockIdx.x, lo = a.ph_lo, hi = a.ph_hi;
    volatile LAS unsigned* bst = (volatile LAS unsigned*)(lds + LDS_BYTES - 16);
    if (threadIdx.x == 0) { bst[0] = 0u; bst[1] = 0u; }
    __syncthreads();
    const XcdBarrier xbar = xcd_barrier_post((unsigned*)(a.ws + WS_BAR), bst);
    if (lo < 0) grid.sync();
    unsigned char* ws = a.ws;
    float* SS = (float*)(ws + WS_SS); float* PPSS = (float*)(ws + WS_PPSS); float* GN = (float*)(ws + WS_GN); float* S00 = (float*)(ws + WS_GN + 1 * MiB);
    const float* CS = (const float*)(ws + WS_ROPE); const float* SN = CS + SEQ * 128;
    bf16_t* WB = (bf16_t*)(ws + WS_W); bf16_t* XB = (bf16_t*)(ws + WS_XB); bf16_t* PB = (bf16_t*)(ws + WS_PB); bf16_t* MIX = (bf16_t*)(ws + WS_MIX);
    bf16_t* XB2 = (bf16_t*)(ws + WS_XB2); bf16_t* BIG = (bf16_t*)(ws + WS_BIG); bf16_t* ACT = (bf16_t*)(ws + WS_ACT); float* EDGE = (float*)(ws + WS_ACT);
#ifndef PHASE_MASK
#define PHASE_MASK 0xffffff
#endif
#define IN(k) (((PHASE_MASK >> (k)) & 1) && lo <= (k) && (k) < hi)
#ifndef DUP_MASK
#define DUP_MASK 0
#ifndef PROBE2_REPS
#define PROBE2_REPS 1
#endif

#ifdef PROBE_0
#define PROBE_P0 p0_prologue(a, lds);
#else
#define PROBE_P0
#endif


#endif
#define REP(k)
#define SEAM(k) do { if (IN(k) && IN((k) + 1)) xcd_barrier(xbar); } while (0)
#define GEMM_M(M_, EPI, Aptr, lda_, Bptr, ldb_, N_, K_, ...) do { pg8::Gemm g{Aptr, Bptr, lda_, ldb_, M_, N_, K_}; pg8::StaticOrder S; S.init(M_, N_, G, bx); pg8::EPI E{__VA_ARGS__}; pg8::gemm_phase<pg8::EPI>(lds, g, S, E); } while (0)
#define GEMM(EPI, ...) GEMM_M(MT, EPI, __VA_ARGS__)
#define GEMM_S(Gs_, cs_, EPI, Aptr, lda_, Bptr, ldb_, N_, K_, ...) do { pg8::Gemm g{Aptr, Bptr, lda_, ldb_, MT, N_, K_}; pg8::StaticOrder S; S.init(MT, N_, Gs_, cs_); pg8::EPI E{__VA_ARGS__}; pg8::gemm_phase<pg8::EPI>(lds, g, S, E); } while (0)

    if (IN(0)) { p0_prologue(a, lds); PROBE_P0 }
    SEAM(0);
    if (IN(1)) REP(1) GEMM(EpiProj0, XB, DM, WB + W_ABIN, DM, AB_IN, DM, BIG, SS);
    SEAM(1);
    if (IN(2)) for (int rep2_ = 0; rep2_ < PROBE2_REPS; ++rep2_) {
        for (int u = bx; u < 2048 + 1024; u += G) {
            if (u < 2048) { const int qc = 15 - (u >> 7), bh = u & 127; sb_unit(lds, BIG, MIX, bh >> 3, bh & 7, qc); }
            else { const int v = u - 2048; sg_unit(lds, BIG, MIX, a.in[I_SGLNG], a.in[I_SGLNB], a.in[I_SGW], a.in[I_SGB], v >> 6, (v >> 2) & 15, v & 3); }
        }
    }
    SEAM(2);
    if (IN(3)) GEMM(EpiRes, MIX, DM, WB + W_ABOUT, DM, DM, DM, a.in[I_X], a.out, XB, SS + 1 * MT);
#ifdef PROBE_P3
    if (IN(3)) GEMM(EpiRes, MIX, DM, WB + W_ABOUT, DM, DM, DM, a.in[I_X], a.out, XB, SS + 7 * MT);
#endif
    SEAM(3);
#if FUSED_FFN
#ifdef PROBE_F
#define PROBE_UPF(l) GEMM(EpiUp, XB, DM, WB + W_UP + (size_t)(l) * UPN * DM, DM, UPN, DM, BIG, EDGE, SS + ((l) == 0 ? 1 : 4) * MT, a.in[I_CONVW] + (size_t)(l) * 3 * UPN, a.in[I_CONVB] + (size_t)(l) * UPN);
#else
#define PROBE_UPF(l)
#endif
#define FFN_LAYER(l, pb) \
    if (IN(pb)) { \
        GEMM(EpiUp, XB, DM, WB + W_UP + (size_t)(l) * UPN * DM, DM, UPN, DM, BIG, EDGE, SS + ((l) == 0 ? 1 : 4) * MT, a.in[I_CONVW] + (size_t)(l) * 3 * UPN, a.in[I_CONVB] + (size_t)(l) * UPN); \
        PROBE_UPF(l) \
        GEMM(EpiPp, PB + (size_t)(l) * MT * PLE, PLE, WB + W_PP + (size_t)(l) * DM * PLE, PLE, DM, PLE, MIX, PPSS + (l) * MT); \
    } \
    SEAM(pb); \
    if (IN((pb) + 1)) fixup_phase(BIG, EDGE, a.in[I_CONVW] + (size_t)(l) * 3 * UPN, a.in[I_CONVB] + (size_t)(l) * UPN); \
    SEAM((pb) + 1); \
    if (IN((pb) + 2)) GEMM(EpiRes, BIG, DFF, WB + W_DOWN + (size_t)(l) * DM * DFF, DFF, DM, DFF, a.out, a.out, XB2, SS + ((l) == 0 ? 2 : 5) * MT); \
    SEAM((pb) + 2); \
    if (IN((pb) + 3)) GEMM(EpiPle, XB2, DM, WB + W_GATE + (size_t)(l) * DM * DM, DM, DM, DM, a.out, a.out, XB, SS + ((l) == 0 ? 2 : 5) * MT, SS + ((l) == 0 ? 3 : 6) * MT, MIX, PPSS + (l) * MT, a.in[I_POSTG] + (l) * DM); \
    SEAM((pb) + 3);
    constexpr int PH_L1 = 8, PH_F1 = 12, PH_FIN = 16;
#else
#define FFN_UP(l, hf) GEMM_M(MH, EpiPlain, XB + (size_t)(hf) * MH * DM, DM, WB + W_UP + (size_t)(l) * UPN * DM, DM, UPN, DM, BIG, SS + ((l) == 0 ? 1 : 4) * MT + (hf) * MH)
#define FFN_DOWN(l, hf) GEMM_M(MH, EpiRes, ACT, DFF, WB + W_DOWN + (size_t)(l) * DM * DFF, DFF, DM, DFF, a.out + (size_t)(hf) * MH * DM, a.out + (size_t)(hf) * MH * DM, XB + (size_t)(hf) * MH * DM, SS + ((l) == 0 ? 2 : 5) * MT + (hf) * MH)
#ifdef PROBE_CONV
#define FFN_CONV(l) do { conv_phase(BIG, ACT, a.in[I_CONVW] + (size_t)(l) * 3 * UPN, a.in[I_CONVB] + (size_t)(l) * UPN); conv_phase(BIG, ACT, a.in[I_CONVW] + (size_t)(l) * 3 * UPN, a.in[I_CONVB] + (size_t)(l) * UPN); } while (0)
#else
#define FFN_CONV(l) conv_phase(BIG, ACT, a.in[I_CONVW] + (size_t)(l) * 3 * UPN, a.in[I_CONVB] + (size_t)(l) * UPN)
#endif
#ifndef PROBE_UP
#define PROBE_UP(l)
#endif
#define FFN_LAYER(l, pb) \
    if (IN(pb)) { FFN_UP(l, 0); \
        if (G == 256) { if (bx >= 128) GEMM_S(128, bx - 128, EpiPp, PB + (size_t)(l) * MT * PLE, PLE, WB + W_PP + (size_t)(l) * DM * PLE, PLE, DM, PLE, MIX, PPSS + (l) * MT); } \
        else GEMM(EpiPp, PB + (size_t)(l) * MT * PLE, PLE, WB + W_PP + (size_t)(l) * DM * PLE, PLE, DM, PLE, MIX, PPSS + (l) * MT); } \
    SEAM(pb); \
    if (IN((pb) + 1)) FFN_CONV(l); \
    SEAM((pb) + 1); \
    if (IN((pb) + 2)) { FFN_DOWN(l, 0); FFN_UP(l, 1); } \
    SEAM((pb) + 2); \
    if (IN((pb) + 3)) FFN_CONV(l); \
    SEAM((pb) + 3); \
    if (IN((pb) + 4)) FFN_DOWN(l, 1); \
    SEAM((pb) + 4); \
    if (IN((pb) + 5)) GEMM(EpiPle, XB, DM, WB + W_GATE + (size_t)(l) * DM * DM, DM, DM, DM, a.out, a.out, XB, SS + ((l) == 0 ? 2 : 5) * MT, SS + ((l) == 0 ? 3 : 6) * MT, MIX, PPSS + (l) * MT, a.in[I_POSTG] + (l) * DM); \
    SEAM((pb) + 5);
    constexpr int PH_L1 = 10, PH_F1 = 14, PH_FIN = 20;
#endif

    FFN_LAYER(0, 4)
    if (IN(PH_L1)) { GEMM(EpiQkv, XB, DM, WB + W_RETIN, DM, RET_QKV, DM, BIG, SS + 3 * MT, CS, SN);
#ifdef PROBE_A
        GEMM(EpiQkv, XB, DM, WB + W_RETIN, DM, RET_QKV, DM, BIG, SS + 3 * MT, CS, SN);
#endif
 s00_phase(lds, S00, a.out, a.in[I_MIXG] + DM, a.in[I_RETIN]); }
    SEAM(PH_L1);
#ifdef PROBE_B
    if (IN(PH_L1 + 1)) { for (int u = bx; u < 256; u += G) ret_unit(lds, BIG, GN, u >> 4, (u >> 2) & 3, u & 3, lo < 0, S00, SS + 3 * MT, lo >= 0); }
#endif
    if (IN(PH_L1 + 1)) {
        for (int u = bx; u < 256; u += G) { const int xcd = u & 7, t = u >> 3, vs = t & 3, pair = xcd + 8 * (t >> 2);
            ret_unit(lds, BIG, GN, pair >> 2, pair & 3, vs, true, S00, SS + 3 * MT); } }
#ifdef EXTRA_SYNCS
    for (int es = 0; es < EXTRA_SYNCS; ++es) xcd_barrier(xbar);
#endif
    SEAM(PH_L1 + 1);
    if (IN(PH_L1 + 2)) GEMM(EpiGate, XB, DM, WB + W_RETIN + (size_t)RET_QKV * DM, DM, RET_V, DM, BIG, SS + 3 * MT, GN, a.in[I_RETGN]);
#ifdef PROBE_A
    if (IN(PH_L1 + 2)) GEMM(EpiGate, XB, DM, WB + W_RETIN + (size_t)RET_QKV * DM, DM, RET_V, DM, BIG, SS + 3 * MT, GN, a.in[I_RETGN]);
#endif
    SEAM(PH_L1 + 2);
    if (IN(PH_L1 + 3)) GEMM(EpiRes, BIG, RET_QKV, WB + W_RETOUT, RET_V, DM, RET_V, a.out, a.out, XB, SS + 4 * MT);
    SEAM(PH_L1 + 3);
    FFN_LAYER(1, PH_F1)
    if (IN(PH_FIN)) final_phase(a.out, SS + 6 * MT, a.in[I_FING]);
#undef IN
#undef SEAM
#undef GEMM
}

extern "C" void kernel_launch(void* const* d_in, const int* in_sizes, int n_in, void* d_out, int out_size, void* d_ws, size_t ws_size, hipStream_t stream) {
    static int grid = 0;
    if (grid == 0) {
        if (n_in != 22 || out_size != MT * DM || ws_size < WS_END) { fprintf(stderr, "kernel_launch: unexpected shapes (n_in %d out %d ws %zu)\n", n_in, out_size, ws_size); grid = -1; return; }
        int dev = 0, cus = 0, per_cu = 0;
        hipGetDevice(&dev); hipDeviceGetAttribute(&cus, hipDeviceAttributeMultiprocessorCount, dev);
        if (hipFuncSetAttribute((const void*)fwd_megakernel, hipFuncAttributeMaxDynamicSharedMemorySize, LDS_BYTES) != hipSuccess) { fprintf(stderr, "kernel_launch: hipFuncSetAttribute failed\n"); grid = -1; return; }
        if (hipOccupancyMaxActiveBlocksPerMultiprocessor(&per_cu, (const void*)fwd_megakernel, NTHR, LDS_BYTES) != hipSuccess || per_cu < 1) { fprintf(stderr, "kernel_launch: occupancy query says %d\n", per_cu); per_cu = 1; }
        (void)hipGetLastError();
        grid = cus;
        fprintf(stderr, "kernel_launch: grid %d (per_cu %d)\n", grid, per_cu);
    }
    if (grid < 0) return;
    if (hipMemsetAsync((char*)d_ws + WS_BAR, 0, 16384, stream) != hipSuccess) { fprintf(stderr, "kernel_launch: memset failed\n"); return; }
    Args a{};
    for (int i = 0; i < 22; ++i) a.in[i] = (const float*)d_in[i];
    a.out = (float*)d_out; a.ws = (unsigned char*)d_ws;
#if MK_N_LAUNCHES == 1
    a.ph_lo = 0; a.ph_hi = N_PHASES;
    void* args[] = {&a};
    hipError_t e = hipLaunchCooperativeKernel((const void*)fwd_megakernel, dim3(grid), dim3(NTHR), args, LDS_BYTES, stream);
    if (e != hipSuccess) fprintf(stderr, "kernel_launch: cooperative launch failed: %s\n", hipGetErrorString(e));
#else
    for (int p = 0; p < N_PHASES; ++p) { a.ph_lo = p; a.ph_hi = p + 1; hipLaunchKernelGGL(fwd_megakernel, dim3(grid), dim3(NTHR), LDS_BYTES, stream, a); }
#endif
}
```
